# Optimizing an MI355X kernel written in HIP

```python
import jax, jax.numpy as jnp
from jax import lax
import numpy as np


D_MODEL = 2048
BATCH = 4
SEQ = 4096
DEPTH = 2

MEM_LEN = 256
BRANCH_W = D_MODEL // 2
N_BRANCH = 4
MOBA_HEADS = 8
MOBA_HEAD_DIM = BRANCH_W // MOBA_HEADS
MOBA_BLOCK = 256
MOBA_TOPK = 3
MOBA_Q_CHUNK = 16
CONV_WIDTH = 3
DSA_HEADS = 8
DSA_HEAD_DIM = BRANCH_W // DSA_HEADS
IDX_HEADS = 4
IDX_DIM = 64
DSA_TOPK_MAX = 256
DSA_Q_CHUNK = 64
MEM_HEADS = 4
MEM_HEAD_DIM = BRANCH_W // MEM_HEADS
EPS = 1e-6

SPLIT_SIZES = (BRANCH_W,) * 14 + (IDX_HEADS * IDX_DIM, IDX_DIM, IDX_HEADS) + (D_MODEL,) * N_BRANCH
IN_COLS = 14 * BRANCH_W + IDX_HEADS * IDX_DIM + IDX_DIM + IDX_HEADS + N_BRANCH * D_MODEL

kernel_name = 'hybrid_moba_conv_dsa_memory_gated'


def _split_points():
    pts, acc = [], 0
    for s in SPLIT_SIZES[:-1]:
        acc += s
        pts.append(acc)
    return pts


def rms_norm(x, g):
    xf = x.astype(jnp.float32)
    y = xf * lax.rsqrt(jnp.mean(xf * xf, axis=-1, keepdims=True) + EPS)
    return (y * g.astype(jnp.float32)).astype(x.dtype)


def moba_attention(q, k, v):
    b, L, h, d = q.shape
    nb = -(-L // MOBA_BLOCK)
    Lp = nb * MOBA_BLOCK
    pad = ((0, 0), (0, Lp - L), (0, 0), (0, 0))
    q, k, v = jnp.pad(q, pad), jnp.pad(k, pad), jnp.pad(v, pad)
    qh = q.transpose(0, 2, 1, 3)
    kb = k.transpose(0, 2, 1, 3).reshape(b, h, nb, MOBA_BLOCK, d)
    vb = v.transpose(0, 2, 1, 3).reshape(b, h, nb, MOBA_BLOCK, d)
    kmean = jnp.mean(kb.astype(jnp.float32), axis=3)
    qblk = jnp.arange(Lp) // MOBA_BLOCK
    bscore = jnp.einsum('bhtd,bhnd->bhtn', qh.astype(jnp.float32), kmean)
    past = jnp.arange(nb)[None, :] < qblk[:, None]
    bscore = jnp.where(past, bscore, -jnp.inf)
    _, top_idx = lax.top_k(bscore, min(MOBA_TOPK, nb))
    own = jnp.broadcast_to(qblk[None, None, :, None], (b, h, Lp, 1)).astype(top_idx.dtype)
    sel = jnp.concatenate([top_idx, own], axis=-1)
    n_sel = sel.shape[-1]
    C = MOBA_Q_CHUNK
    n_chunks = Lp // C
    qs = qh.reshape(b, h, n_chunks, C, d).transpose(2, 0, 1, 3, 4)
    sels = sel.reshape(b, h, n_chunks, C, n_sel).transpose(2, 0, 1, 3, 4)
    gather = jax.vmap(jax.vmap(lambda blocks, ix: blocks[ix]))
    scale = d ** -0.5
    is_own = (jnp.arange(n_sel) == n_sel - 1)[:, None]

    def chunk(args):
        qc, selc, cid = args
        t = cid * C + jnp.arange(C)
        kg = gather(kb, selc)
        vg = gather(vb, selc)
        s = jnp.einsum('bhcd,bhcnkd->bhcnk', qc, kg).astype(jnp.float32) * scale
        kpos = selc[..., None] * MOBA_BLOCK + jnp.arange(MOBA_BLOCK)
        valid = jnp.where(is_own, kpos <= t[:, None, None],
                          selc[..., None] < (t // MOBA_BLOCK)[:, None, None])
        s = jnp.where(valid, s, -jnp.inf)
        p = jax.nn.softmax(s.reshape(b, h, C, n_sel * MOBA_BLOCK), axis=-1)
        p = p.reshape(b, h, C, n_sel, MOBA_BLOCK).astype(vg.dtype)
        return jnp.einsum('bhcnk,bhcnkd->bhcd', p, vg)

    o = lax.map(chunk, (qs, sels, jnp.arange(n_chunks)))
    o = o.transpose(1, 2, 0, 3, 4).reshape(b, h, Lp, d).transpose(0, 2, 1, 3)
    return o[:, :L]


def short_conv(u, w, bias):
    y = lax.conv_general_dilated(u, w.astype(u.dtype)[:, None, :], window_strides=(1,),
                                 padding=[(CONV_WIDTH - 1, 0)],
                                 dimension_numbers=('NWC', 'WIO', 'NWC'),
                                 feature_group_count=u.shape[-1])
    return y + bias.astype(u.dtype)


def dsa_attention(q, k, v, qi, ki, wi):
    b, L, h, d = q.shape
    topk = min(DSA_TOPK_MAX, L // 4)
    C = DSA_Q_CHUNK
    n_chunks = L // C
    qs = q.reshape(b, n_chunks, C, h, d).transpose(1, 0, 2, 3, 4)
    qis = qi.reshape(b, n_chunks, C, IDX_HEADS, IDX_DIM).transpose(1, 0, 2, 3, 4)
    wis = wi.reshape(b, n_chunks, C, IDX_HEADS).transpose(1, 0, 2, 3)
    kif = ki.astype(jnp.float32)
    gather = jax.vmap(lambda kk, ix: kk[ix])
    scale = d ** -0.5
    idx_scale = (IDX_DIM ** -0.5) * (IDX_HEADS ** -0.5)
    key_pos = jnp.arange(L)

    def chunk(args):
        qc, qic, wic, cid = args
        t = cid * C + jnp.arange(C)
        logits = jnp.einsum('bcji,bsi->bcjs', qic.astype(jnp.float32), kif)
        score = jnp.einsum('bcj,bcjs->bcs', wic.astype(jnp.float32) * idx_scale,
                           jax.nn.relu(logits))
        score = jnp.where(key_pos[None, None, :] <= t[None, :, None], score, -jnp.inf)
        _, idx = lax.top_k(score, topk)
        kg = gather(k, idx)
        vg = gather(v, idx)
        s = jnp.einsum('bchd,bckhd->bhck', qc, kg).astype(jnp.float32) * scale
        valid = (idx <= t[None, :, None])[:, None]
        p = jax.nn.softmax(jnp.where(valid, s, -jnp.inf), axis=-1).astype(vg.dtype)
        return jnp.einsum('bhck,bckhd->bchd', p, vg)

    o = lax.map(chunk, (qs, qis, wis, jnp.arange(n_chunks)))
    return o.transpose(1, 0, 2, 3, 4).reshape(b, L, h, d)


def memory_attention(q, mk, mv):
    s = jnp.einsum('bthd,bmhd->bhtm', q, mk).astype(jnp.float32) * (q.shape[-1] ** -0.5)
    p = jax.nn.softmax(s, axis=-1).astype(mv.dtype)
    return jnp.einsum('bhtm,bmhd->bthd', p, mv)


def hybrid_layer(x, mem, ln_g, w_in, conv_w, conv_b, mem_ln_g, w_mem_kv, w_branch, w_out):
    b, L, _ = x.shape
    xn = rms_norm(x, ln_g)
    cols = jnp.split(w_in, _split_points(), axis=1)
    (a_q, a_k, a_v, a_g, c_b, c_c, c_h, c_g, s_q, s_k, s_v, s_g, m_q, m_g,
     i_q, i_k, i_w, r_a, r_c, r_s, r_m) = [xn @ w for w in cols]

    def heads(t, n, d):
        return t.reshape(b, L, n, d)

    y_a = moba_attention(heads(a_q, MOBA_HEADS, MOBA_HEAD_DIM), heads(a_k, MOBA_HEADS, MOBA_HEAD_DIM),
                         heads(a_v, MOBA_HEADS, MOBA_HEAD_DIM)).reshape(b, L, BRANCH_W)
    y_a = y_a * jax.nn.silu(a_g)
    y_c = c_b * short_conv(c_c * c_h, conv_w, conv_b) * jax.nn.silu(c_g)
    y_s = dsa_attention(heads(s_q, DSA_HEADS, DSA_HEAD_DIM), heads(s_k, DSA_HEADS, DSA_HEAD_DIM),
                        heads(s_v, DSA_HEADS, DSA_HEAD_DIM), heads(i_q, IDX_HEADS, IDX_DIM),
                        i_k, i_w).reshape(b, L, BRANCH_W)
    y_s = y_s * jax.nn.silu(s_g)
    mem_n = rms_norm(mem, mem_ln_g)
    mk, mv = jnp.split(mem_n @ w_mem_kv, 2, axis=-1)
    M = mem.shape[1]
    y_m = memory_attention(heads(m_q, MEM_HEADS, MEM_HEAD_DIM),
                           mk.reshape(b, M, MEM_HEADS, MEM_HEAD_DIM),
                           mv.reshape(b, M, MEM_HEADS, MEM_HEAD_DIM)).reshape(b, L, BRANCH_W)
    y_m = y_m * jax.nn.silu(m_g)
    merged = (jax.nn.sigmoid(r_a) * (y_a @ w_branch[0]) + jax.nn.sigmoid(r_c) * (y_c @ w_branch[1])
              + jax.nn.sigmoid(r_s) * (y_s @ w_branch[2]) + jax.nn.sigmoid(r_m) * (y_m @ w_branch[3]))
    return x + merged @ w_out


def setup_inputs(seed: int = 0) -> dict:
    key = jax.random.key(seed)
    ks = jax.random.split(key, 11)
    f32 = jnp.float32
    x = jax.random.normal(ks[0], (BATCH, SEQ, D_MODEL), f32)
    mem = jax.random.normal(ks[1], (BATCH, MEM_LEN, D_MODEL), f32)
    ln_g = 1.0 + 0.02 * jax.random.normal(ks[2], (DEPTH, D_MODEL), f32)
    w_in = jax.random.normal(ks[3], (DEPTH, D_MODEL, IN_COLS), f32) * D_MODEL ** -0.5
    conv_w = jax.random.normal(ks[4], (DEPTH, CONV_WIDTH, BRANCH_W), f32) * CONV_WIDTH ** -0.5
    conv_b = 0.02 * jax.random.normal(ks[5], (DEPTH, BRANCH_W), f32)
    mem_ln_g = 1.0 + 0.02 * jax.random.normal(ks[6], (DEPTH, D_MODEL), f32)
    w_mem_kv = jax.random.normal(ks[7], (DEPTH, D_MODEL, 2 * BRANCH_W), f32) * D_MODEL ** -0.5
    w_branch = jax.random.normal(ks[8], (DEPTH, N_BRANCH, BRANCH_W, D_MODEL), f32) * BRANCH_W ** -0.5
    w_out = jax.random.normal(ks[9], (DEPTH, D_MODEL, D_MODEL), f32) * D_MODEL ** -0.5
    final_g = 1.0 + 0.02 * jax.random.normal(ks[10], (D_MODEL,), f32)
    return {'x': x, 'mem': mem, 'ln_g': ln_g, 'w_in': w_in, 'conv_w': conv_w, 'conv_b': conv_b,
            'mem_ln_g': mem_ln_g, 'w_mem_kv': w_mem_kv, 'w_branch': w_branch, 'w_out': w_out,
            'final_g': final_g}


def reference(x, mem, ln_g, w_in, conv_w, conv_b, mem_ln_g, w_mem_kv, w_branch, w_out, final_g):
    for layer in range(DEPTH):
        x = hybrid_layer(x, mem, ln_g[layer], w_in[layer], conv_w[layer], conv_b[layer],
                         mem_ln_g[layer], w_mem_kv[layer], w_branch[layer], w_out[layer])
    return rms_norm(x, final_g)
```

```cpp
#include <hip/hip_runtime.h>
#include <cstdio>
#include <cstdint>

#define LAS __attribute__((address_space(3)))
#define GAS __attribute__((address_space(1)))
typedef unsigned short bf16_t;
typedef short bf16x8 __attribute__((ext_vector_type(8)));
typedef float f32x4 __attribute__((ext_vector_type(4)));
typedef float f32x2 __attribute__((ext_vector_type(2)));
typedef unsigned u32x4 __attribute__((ext_vector_type(4)));
typedef unsigned u32x2 __attribute__((ext_vector_type(2)));

constexpr int DM = 2048, NB = 4, SEQ = 4096, M = NB * SEQ, MEML = 256, BW = 1024;
constexpr int NIN = 22852, NP = 23040;
constexpr float EPS = 1e-6f;
constexpr int C_AQ = 0, C_AK = 1024, C_AV = 2048, C_AG = 3072, C_CB = 4096, C_CC = 5120, C_CH = 6144, C_CG = 7168;
constexpr int C_SQ = 8192, C_SK = 9216, C_SV = 10240, C_SG = 11264, C_MQ = 12288, C_MG = 13312, C_IDX = 14336, C_R = 14848;
constexpr size_t MiB = 1u << 20;
constexpr size_t WS_CTL = 0, CTL_BYTES = 1 * MiB;
constexpr size_t SZ_WIN = (size_t)NP * DM * 2, SZ_WKV = (size_t)2048 * DM * 2, SZ_WBR = (size_t)4 * DM * BW * 2, SZ_WOUT = (size_t)DM * DM * 2;
constexpr size_t WS_WIN = 1 * MiB;
constexpr size_t WS_WKV = WS_WIN + 2 * SZ_WIN;
constexpr size_t WS_WBR = WS_WKV + 2 * SZ_WKV;
constexpr size_t WS_WOUT = WS_WBR + 2 * SZ_WBR;
constexpr size_t WS_XN = WS_WOUT + 2 * SZ_WOUT;
constexpr size_t WS_MEMN = WS_XN + (size_t)M * DM * 2;
constexpr size_t WS_KVM = WS_MEMN + 2 * (size_t)1024 * DM * 2;
constexpr size_t WS_PO = WS_KVM + 2 * (size_t)1024 * 2048 * 2;
constexpr size_t WS_IDX = WS_PO + (size_t)M * NP * 2;
constexpr size_t WS_Y = WS_IDX + (size_t)M * 512 * 4;
constexpr size_t WS_MASK = WS_Y + (size_t)M * 4096 * 2;
constexpr size_t WS_KMEAN = WS_MASK + (size_t)4 * 128 * 4096 * 4;
constexpr size_t WS_END = WS_KMEAN + (size_t)4 * 8 * 16 * 128 * 4;

__device__ __forceinline__ unsigned f2bf(float f) { unsigned u = __builtin_bit_cast(unsigned, f); return (u + 0x7fffu + ((u >> 16) & 1u)) >> 16; }
__device__ __forceinline__ unsigned pk2(float lo, float hi) { return f2bf(lo) | (f2bf(hi) << 16); }
__device__ __forceinline__ float bf2f(unsigned short h) { return __builtin_bit_cast(float, (unsigned)h << 16); }
__device__ __forceinline__ float bflo(unsigned w) { return __builtin_bit_cast(float, w << 16); }
__device__ __forceinline__ float bfhi(unsigned w) { return __builtin_bit_cast(float, w & 0xffff0000u); }
__device__ __forceinline__ float sigmoidf_(float x) { return 1.0f / (1.0f + __expf(-x)); }
__device__ __forceinline__ float siluf_(float x) { return x / (1.0f + __expf(-x)); }

namespace pg8 {
constexpr int BM = 256, BK = 64, HALF = 128, HTB = HALF * BK * 2, STAGE_BYTES = 8 * HTB, NXCD = 8, WGM = 8;
__host__ __device__ __forceinline__ int lds_byte(int r, int c) { const int st = (r >> 4) * 2 + (c >> 5), rr = r & 15, cc = c & 31, ob = rr * 64 + cc * 2; return st * 1024 + (ob ^ (((ob >> 9) & 1) << 5)); }
__host__ __device__ __forceinline__ void stage_rc(int b, int& R, int& C) { const int st = b / 1024, sb = b % 1024, swz = sb ^ (((sb >> 9) & 1) << 5); R = (st >> 1) * 16 + swz / 64; C = (st & 1) * 32 + (swz % 64) / 2; }
__host__ __device__ __forceinline__ int perm32(int rho) { const int n = rho >> 4, i = rho & 15; return 8 * (i >> 2) + 4 * n + (i & 3); }

struct Unit { int pm, pn, z; };
struct Gemm { const bf16_t* A; const bf16_t* Bt; int K, lda, ldb; size_t azs, bzs; };

struct Sched {
    int nM, nN, nZ, zinner, G, c;
    __device__ __forceinline__ bool next(int i, Unit& u) const {
        const int nwg = nM * nN; long L; int zi;
        if (zinner) { zi = i % nZ; L = (long)(i / nZ) * G + c; if (L >= nwg) return false; }
        else { L = (long)i * G + c; if (L >= (long)nwg * nZ) return false; zi = (int)(L / nwg); L = L % nwg; }
        int wgid = (int)L; { const int q = nwg / NXCD, r = nwg % NXCD, xcd = wgid % NXCD, off = wgid / NXCD; wgid = (xcd < r ? xcd * (q + 1) : r * (q + 1) + (xcd - r) * q) + off; }
        const int nig = WGM * nN, gid = wgid / nig, fm = gid * WGM, gsz = (nM - fm) < WGM ? (nM - fm) : WGM;
        u.pm = fm + ((wgid % nig) % gsz); u.pn = (wgid % nig) / gsz; u.z = zi; return true;
    }
};

struct EpiInProj {
    static constexpr bool PERM = true;
    bf16_t* PO; float* IDX;
    __device__ __forceinline__ void operator()(const f32x4 (&acc)[2][2][4][2], const Unit& u, int wr, int wc, int fr, int fq) const {
        const int pn = u.pn;
        const int act = (pn >= 58) ? 2 : (((pn >= 12 && pn < 16) || (pn >= 28 && pn < 32) || (pn >= 44 && pn < 48) || (pn >= 52 && pn < 56)) ? 1 : 0);
        const int row0 = u.pm * BM + wr * 64 + fr, col0 = pn * BM + wc * 32 + 8 * fq;
#pragma unroll
        for (int ai = 0; ai < 2; ++ai)
#pragma unroll
            for (int m = 0; m < 4; ++m) { const int row = row0 + ai * HALF + m * 16; bf16_t* rowp = PO + (size_t)row * NP + col0;
#pragma unroll
                for (int bj = 0; bj < 2; ++bj) { f32x4 v0 = acc[ai][bj][m][0], v1 = acc[ai][bj][m][1];
                    if (act == 1) { v0 = (f32x4){siluf_(v0[0]), siluf_(v0[1]), siluf_(v0[2]), siluf_(v0[3])}; v1 = (f32x4){siluf_(v1[0]), siluf_(v1[1]), siluf_(v1[2]), siluf_(v1[3])}; }
                    else if (act == 2) { v0 = (f32x4){sigmoidf_(v0[0]), sigmoidf_(v0[1]), sigmoidf_(v0[2]), sigmoidf_(v0[3])}; v1 = (f32x4){sigmoidf_(v1[0]), sigmoidf_(v1[1]), sigmoidf_(v1[2]), sigmoidf_(v1[3])}; }
                    u32x4 w; w.x = pk2(v0[0], v0[1]); w.y = pk2(v0[2], v0[3]); w.z = pk2(v1[0], v1[1]); w.w = pk2(v1[2], v1[3]);
                    *(u32x4*)(rowp + bj * HALF) = w;
                    if (pn == 56 || pn == 57) { float* ip = IDX + (size_t)row * 512 + (pn - 56) * 256 + wc * 32 + 8 * fq + bj * HALF; *(f32x4*)ip = v0; *(f32x4*)(ip + 4) = v1; }
                } }
    }
};
struct EpiBf16 {
    static constexpr bool PERM = true;
    bf16_t* O; int ldc; size_t zstride;
    __device__ __forceinline__ void operator()(const f32x4 (&acc)[2][2][4][2], const Unit& u, int wr, int wc, int fr, int fq) const {
        const int row0 = u.pm * BM + wr * 64 + fr, col0 = u.pn * BM + wc * 32 + 8 * fq; bf16_t* base = O + (size_t)u.z * zstride;
#pragma unroll
        for (int ai = 0; ai < 2; ++ai)
#pragma unroll
            for (int m = 0; m < 4; ++m) { bf16_t* rowp = base + (size_t)(row0 + ai * HALF + m * 16) * ldc + col0;
#pragma unroll
                for (int bj = 0; bj < 2; ++bj) { const f32x4 v0 = acc[ai][bj][m][0], v1 = acc[ai][bj][m][1];
                    u32x4 w; w.x = pk2(v0[0], v0[1]); w.y = pk2(v0[2], v0[3]); w.z = pk2(v1[0], v1[1]); w.w = pk2(v1[2], v1[3]);
                    *(u32x4*)(rowp + bj * HALF) = w; } }
    }
};
struct EpiMerge {
    static constexpr bool PERM = true;
    bf16_t* PO;
    __device__ __forceinline__ void operator()(const f32x4 (&acc)[2][2][4][2], const Unit& u, int wr, int wc, int fr, int fq) const {
        const int row0 = u.pm * BM + wr * 64 + fr, col0 = u.pn * BM + wc * 32 + 8 * fq; const int z = u.z;
#pragma unroll
        for (int ai = 0; ai < 2; ++ai)
#pragma unroll
            for (int m = 0; m < 4; ++m) { bf16_t* rowb = PO + (size_t)(row0 + ai * HALF + m * 16) * NP;
#pragma unroll
                for (int bj = 0; bj < 2; ++bj) { const int c = col0 + bj * HALF;
                    const u32x4 g = *(const u32x4*)(rowb + C_R + z * 2048 + c);
                    f32x4 v0 = acc[ai][bj][m][0], v1 = acc[ai][bj][m][1];
                    v0 = (f32x4){v0[0] * bflo(g.x), v0[1] * bfhi(g.x), v0[2] * bflo(g.y), v0[3] * bfhi(g.y)};
                    v1 = (f32x4){v1[0] * bflo(g.z), v1[1] * bfhi(g.z), v1[2] * bflo(g.w), v1[3] * bfhi(g.w)};
                    float* pp = (float*)rowb + c;
                    if (z > 0) { v0 += *(const f32x4*)pp; v1 += *(const f32x4*)(pp + 4); }
                    if (z < 3) { *(f32x4*)pp = v0; *(f32x4*)(pp + 4) = v1; }
                    else { u32x4 w; w.x = pk2(v0[0], v0[1]); w.y = pk2(v0[2], v0[3]); w.z = pk2(v1[0], v1[1]); w.w = pk2(v1[2], v1[3]); *(u32x4*)(rowb + 4096 + c) = w; }
                } }
    }
};
struct EpiOut {
    static constexpr bool PERM = false;
    const float* resid; float* out;
    __device__ __forceinline__ void operator()(const f32x4 (&acc)[2][2][4][2], const Unit& u, int wr, int wc, int fr, int fq) const {
        const int row0 = u.pm * BM + wr * 64 + fr, col0 = u.pn * BM + wc * 32 + 4 * fq;
#pragma unroll
        for (int ai = 0; ai < 2; ++ai)
#pragma unroll
            for (int m = 0; m < 4; ++m) { const size_t ro = (size_t)(row0 + ai * HALF + m * 16) * DM + col0;
#pragma unroll
                for (int bj = 0; bj < 2; ++bj)
#pragma unroll
                    for (int n = 0; n < 2; ++n) { const f32x4 r = *(const f32x4*)(resid + ro + bj * HALF + n * 16); *(f32x4*)(out + ro + bj * HALF + n * 16) = acc[ai][bj][m][n] + r; } }
    }
};

template <class Epi, bool ALIGN_EPI>
__device__ __forceinline__ void gemm_phase(LAS unsigned char* lds, const Gemm g, const Sched& S, const Epi& E) {
    int tid_ = threadIdx.x; asm volatile("" : "+v"(tid_));
    const int tid = tid_, wid = __builtin_amdgcn_readfirstlane(tid >> 6), lane = tid & 63, wr = wid >> 2, wc = wid & 3, fr = lane & 15, fq = lane >> 4;
    const int K = g.K, nt = K / BK;
    unsigned voffA[2], voffB[2];
#pragma unroll
    for (int i = 0; i < 2; ++i) { int R, C; stage_rc(tid * 16 + i * 8192, R, C); const int Rb = Epi::PERM ? ((R & ~31) + perm32(R & 31)) : R;
        voffA[i] = (unsigned)(R * g.lda + C) * 2u; voffB[i] = (unsigned)(Rb * g.ldb + C) * 2u; }
    const size_t kstep = (size_t)(BK * 2);
    const size_t hsA = (size_t)HALF * g.lda * 2, hsB = (size_t)HALF * g.ldb * 2;
    const size_t tsA = 2 * hsA, tsB = 2 * hsB;
    const unsigned ldsw = (unsigned)wid * 1024u;
    const int aoff = lds_byte(wr * 64 + fr, fq * 8), boff = lds_byte(wc * 32 + fr, fq * 8);
#define PG8_SA(b, h) (((b) * 2 + (h)) * HTB)
#define PG8_SB(b, h) ((4 + (b) * 2 + (h)) * HTB)
#define PG8_STAGE(bufoff, gbase, voff) do { _Pragma("unroll") for (int _i = 0; _i < 2; ++_i) \
        __builtin_amdgcn_global_load_lds((const unsigned*)((const char*)(gbase) + (voff)[_i]), (LAS unsigned*)(lds + (bufoff) + ldsw + _i * 8192), 16, 0, 0); } while (0)
#define PG8_LDA(dst, b, h) do { _Pragma("unroll") for (int m = 0; m < 4; ++m) _Pragma("unroll") for (int k = 0; k < 2; ++k) dst[m][k] = *(const LAS bf16x8*)(lds + PG8_SA(b, h) + aoff + m * 2048 + k * 1024); } while (0)
#define PG8_LDB(dst, b, h) do { _Pragma("unroll") for (int n = 0; n < 2; ++n) _Pragma("unroll") for (int k = 0; k < 2; ++k) dst[n][k] = *(const LAS bf16x8*)(lds + PG8_SB(b, h) + boff + n * 2048 + k * 1024); } while (0)
#define PG8_MMA(ai, bj, At, Bt) do { __builtin_amdgcn_s_setprio(1); _Pragma("unroll") for (int m = 0; m < 4; ++m) _Pragma("unroll") for (int n = 0; n < 2; ++n) _Pragma("unroll") for (int k = 0; k < 2; ++k) \
        acc[ai][bj][m][n] = __builtin_amdgcn_mfma_f32_16x16x32_bf16(Bt[n][k], At[m][k], acc[ai][bj][m][n], 0, 0, 0); __builtin_amdgcn_s_setprio(0); } while (0)
#define PG8_WAIT_V(n) asm volatile("s_waitcnt vmcnt(" #n ")" ::: "memory")
#define PG8_WAIT_L(n) asm volatile("s_waitcnt lgkmcnt(" #n ")" ::: "memory")
#define PG8_BAR __builtin_amdgcn_s_barrier()
#define PG8_SCHED __builtin_amdgcn_sched_barrier(0)
    Unit cur, nxt; int ui = 0;
    if (!S.next(0, cur)) return;
    f32x4 acc[2][2][4][2];
#pragma unroll
    for (int a = 0; a < 2; ++a)
#pragma unroll
        for (int b = 0; b < 2; ++b)
#pragma unroll
            for (int m = 0; m < 4; ++m)
#pragma unroll
                for (int n = 0; n < 2; ++n) acc[a][b][m][n] = (f32x4){0.f, 0.f, 0.f, 0.f};
    bf16x8 At[4][2], B0[2][2], B1[2][2];
    const char* cA = (const char*)g.A + (size_t)cur.pm * tsA + (size_t)cur.z * g.azs; const char* cB = (const char*)g.Bt + (size_t)cur.pn * tsB + (size_t)cur.z * g.bzs;
    PG8_STAGE(PG8_SB(0, 0), cB, voffB); PG8_STAGE(PG8_SB(0, 1), cB + hsB, voffB); PG8_STAGE(PG8_SA(0, 0), cA, voffA); PG8_STAGE(PG8_SA(0, 1), cA + hsA, voffA);
    if (wr == 1) PG8_BAR;
    PG8_WAIT_V(2); PG8_BAR;
    PG8_STAGE(PG8_SB(1, 0), cB + kstep, voffB); PG8_STAGE(PG8_SA(1, 0), cA + kstep, voffA); PG8_STAGE(PG8_SB(1, 1), cB + hsB + kstep, voffB);
    PG8_WAIT_V(6); PG8_BAR;
    for (;;) {
        const bool has_next = S.next(ui + 1, nxt);
        const char* nA = has_next ? (const char*)g.A + (size_t)nxt.pm * tsA + (size_t)nxt.z * g.azs : cA;
        const char* nB = has_next ? (const char*)g.Bt + (size_t)nxt.pn * tsB + (size_t)nxt.z * g.bzs : cB;
        for (int t = 0; t < nt; t += 2) {
            const bool last = (t == nt - 2);
            const char* a1 = cA + (size_t)(t + 1) * kstep;
            const char* a2 = last ? nA : cA + (size_t)(t + 2) * kstep; const char* b2 = last ? nB : cB + (size_t)(t + 2) * kstep;
            const char* a3 = a2 + kstep; const char* b3 = b2 + kstep;
            PG8_LDB(B0, 0, 0); PG8_LDB(B1, 0, 1); PG8_SCHED; PG8_LDA(At, 0, 0); PG8_STAGE(PG8_SA(1, 1), a1 + hsA, voffA);
            PG8_WAIT_V(8); PG8_WAIT_L(0); PG8_BAR; PG8_MMA(0, 0, At, B0); PG8_MMA(0, 1, At, B1); PG8_BAR; PG8_SCHED;
            PG8_LDA(At, 0, 1); PG8_STAGE(PG8_SB(0, 0), b2, voffB); PG8_STAGE(PG8_SB(0, 1), b2 + hsB, voffB); PG8_STAGE(PG8_SA(0, 0), a2, voffA);
            PG8_WAIT_V(8); PG8_WAIT_L(0); PG8_BAR; PG8_MMA(1, 0, At, B0); PG8_MMA(1, 1, At, B1); PG8_BAR; PG8_SCHED;
            PG8_LDB(B0, 1, 0); PG8_LDB(B1, 1, 1); PG8_SCHED; PG8_LDA(At, 1, 0); PG8_STAGE(PG8_SA(0, 1), a2 + hsA, voffA);
            PG8_WAIT_V(8); PG8_WAIT_L(0); PG8_BAR; PG8_MMA(0, 0, At, B0); PG8_MMA(0, 1, At, B1); PG8_BAR; PG8_SCHED;
            PG8_LDA(At, 1, 1); PG8_STAGE(PG8_SB(1, 0), b3, voffB); PG8_STAGE(PG8_SB(1, 1), b3 + hsB, voffB); PG8_STAGE(PG8_SA(1, 0), a3, voffA);
            PG8_WAIT_V(8); PG8_WAIT_L(0); PG8_BAR; PG8_MMA(1, 0, At, B0); PG8_MMA(1, 1, At, B1); PG8_BAR; PG8_SCHED;
        }
        if constexpr (ALIGN_EPI) { if (wr == 0) PG8_BAR; }
        E(acc, cur, wr, wc, fr, fq);
        if (!has_next) break;
#pragma unroll
        for (int a = 0; a < 2; ++a)
#pragma unroll
            for (int b = 0; b < 2; ++b)
#pragma unroll
                for (int m = 0; m < 4; ++m)
#pragma unroll
                    for (int n = 0; n < 2; ++n) acc[a][b][m][n] = (f32x4){0.f, 0.f, 0.f, 0.f};
        cur = nxt; cA = nA; cB = nB; ++ui;
        if constexpr (ALIGN_EPI) { if (wr == 1) PG8_BAR; }
    }
    PG8_WAIT_V(0);
    if constexpr (!ALIGN_EPI) { if (wr == 0) PG8_BAR; }
    PG8_BAR;
#undef PG8_SA
#undef PG8_SB
#undef PG8_STAGE
#undef PG8_LDA
#undef PG8_LDB
#undef PG8_MMA
#undef PG8_WAIT_V
#undef PG8_WAIT_L
#undef PG8_BAR
#undef PG8_SCHED
}
}

constexpr int NWAVES = 8;
constexpr int RING_OFF = 0, RING_BYTES = 131072, MISC_OFF = RING_BYTES + 320, LDS_BYTES = 147456;
#define LDS_WAIT() asm volatile("s_waitcnt lgkmcnt(0)" ::: "memory")

struct Args {
    const float *x, *mem, *ln_g, *w_in, *conv_w, *conv_b, *mem_ln_g, *w_mem_kv, *w_branch, *w_out, *final_g;
    float* out; unsigned char* ws; int ph_lo, ph_hi;
};

__device__ __forceinline__ float wave_sum(float v) {
#pragma unroll
    for (int o = 1; o < 64; o <<= 1) v += __shfl_xor(v, o);
    return v;
}
template <bool INMAP>
__device__ __forceinline__ void transpose_item(const float* W, int K, int ldw, int Npad, bf16_t* WT, LAS float* scr, int item, int lane) {
    const int nblk = Npad / 32, kb = item / nblk, nb = item % nblk, k0 = 64 * kb, n0 = 32 * nb;
    const int n = n0 + (lane & 31);
    int src = n; bool valid = true;
    if (INMAP) { if (n >= 14848) src = n - 188; else if (n >= 14660) valid = false; }
#pragma unroll 8
    for (int i = 0; i < 32; ++i) { const int kk = 2 * i + (lane >> 5); scr[kk * 33 + (lane & 31)] = valid ? W[(size_t)(k0 + kk) * ldw + src] : 0.f; }
    LDS_WAIT(); asm volatile("" ::: "memory");
    const int c = lane & 7;
#pragma unroll
    for (int j = 0; j < 4; ++j) { const int nn = (lane >> 3) + 8 * j; const LAS float* s = scr + (8 * c) * 33 + nn;
        u32x4 o; o.x = pk2(s[0 * 33], s[1 * 33]); o.y = pk2(s[2 * 33], s[3 * 33]); o.z = pk2(s[4 * 33], s[5 * 33]); o.w = pk2(s[6 * 33], s[7 * 33]);
        *(u32x4*)(WT + (size_t)(n0 + nn) * K + k0 + 8 * c) = o; }
    LDS_WAIT(); asm volatile("" ::: "memory");
}
template <bool OUTF>
__device__ __forceinline__ void rms_row(const float* xrow, const float* g, void* orow, int lane) {
    const f32x4* xr = (const f32x4*)xrow + lane; const f32x4* gr = (const f32x4*)g + lane;
    f32x4 v[8]; float s = 0.f;
#pragma unroll
    for (int j = 0; j < 8; ++j) { v[j] = xr[64 * j]; s += (v[j].x * v[j].x + v[j].y * v[j].y) + (v[j].z * v[j].z + v[j].w * v[j].w); }
    const float r = 1.0f / sqrtf(wave_sum(s) * (1.f / DM) + EPS);
#pragma unroll
    for (int j = 0; j < 8; ++j) { const f32x4 gg = gr[64 * j]; const f32x4 y = (f32x4){v[j].x * r * gg.x, v[j].y * r * gg.y, v[j].z * r * gg.z, v[j].w * r * gg.w};
        if (OUTF) ((f32x4*)orow)[lane + 64 * j] = y;
        else ((u32x2*)orow)[lane + 64 * j] = (u32x2){pk2(y.x, y.y), pk2(y.z, y.w)}; }
}

__global__ void __launch_bounds__(NWAVES * 64, 2) fwd(Args a) {
    extern __shared__ __attribute__((aligned(16))) unsigned char lds_raw[];
    LAS unsigned char* lds = (LAS unsigned char*)lds_raw;
    const int tid = threadIdx.x, lane = tid & 63, wave = __builtin_amdgcn_readfirstlane(tid >> 6);
    const int G = gridDim.x, bx = blockIdx.x;
    const int vcu = (G % 8 == 0) ? (bx % 8) * (G / 8) + bx / 8 : bx;
    unsigned char* ws = a.ws;
    bf16_t* XN = (bf16_t*)(ws + WS_XN); bf16_t* PO = (bf16_t*)(ws + WS_PO); float* IDX = (float*)(ws + WS_IDX); bf16_t* Y = (bf16_t*)(ws + WS_Y);
    const int lo = a.ph_lo, hi = a.ph_hi;
#ifndef PHMASK
#define PHMASK 0xffff
#endif
#define IN(k) (lo <= (k) && (k) < hi)
    if (IN(0) && (PHMASK & 1)) {
        LAS float* scr = (LAS float*)(lds + RING_OFF + wave * 16384);
        const int gw = vcu * NWAVES + wave, NGW = G * NWAVES;
        constexpr int I_IN = (DM / 64) * (NP / 32), I_KV = (DM / 64) * (2048 / 32), I_BR = (BW / 64) * (DM / 32), I_OUT = (DM / 64) * (DM / 32);
        constexpr int PER_L = I_IN + I_KV + 4 * I_BR + I_OUT;
        for (int it = gw; it < 2 * PER_L; it += NGW) {
            const int L = it / PER_L; int r = it % PER_L;
            if (r < I_IN) { transpose_item<true>(a.w_in + (size_t)L * DM * NIN, DM, NIN, NP, (bf16_t*)(ws + WS_WIN + L * SZ_WIN), scr, r, lane); continue; } r -= I_IN;
            if (r < I_KV) { transpose_item<false>(a.w_mem_kv + (size_t)L * DM * 2048, DM, 2048, 2048, (bf16_t*)(ws + WS_WKV + L * SZ_WKV), scr, r, lane); continue; } r -= I_KV;
            if (r < 4 * I_BR) { const int z = r / I_BR; transpose_item<false>(a.w_branch + ((size_t)L * 4 + z) * BW * DM, BW, DM, DM, (bf16_t*)(ws + WS_WBR + L * SZ_WBR) + (size_t)z * DM * BW, scr, r % I_BR, lane); continue; } r -= 4 * I_BR;
            transpose_item<false>(a.w_out + (size_t)L * DM * DM, DM, DM, DM, (bf16_t*)(ws + WS_WOUT + L * SZ_WOUT), scr, r, lane);
        }
        for (int m = gw; m < M; m += NGW) rms_row<false>(a.x + (size_t)m * DM, a.ln_g, XN + (size_t)m * DM, lane);
        for (int m = gw; m < 2 * 1024; m += NGW) { const int L = m / 1024, r = m % 1024;
            rms_row<false>(a.mem + (size_t)r * DM, a.mem_ln_g + L * DM, (bf16_t*)(ws + WS_MEMN) + (size_t)m * DM, lane); }
    }
    if (IN(1) && (PHMASK & 2)) {
        pg8::Gemm g{(const bf16_t*)(ws + WS_MEMN), (const bf16_t*)(ws + WS_WKV), DM, DM, DM, (size_t)1024 * DM * 2, SZ_WKV};
        pg8::Sched S{4, 8, 2, 0, G, bx};
        pg8::EpiBf16 E{(bf16_t*)(ws + WS_KVM), 2048, (size_t)1024 * 2048};
        pg8::gemm_phase<pg8::EpiBf16, true>(lds + RING_OFF, g, S, E);
    }
#pragma unroll 1
    for (int L = 0; L < 2; ++L) {
        const int pb = 2 + 6 * L;
        if (IN(pb + 0) && (PHMASK & 4)) {
            pg8::Gemm g{XN, (const bf16_t*)(ws + WS_WIN + L * SZ_WIN), DM, DM, DM, 0, 0};
            pg8::Sched S{M / 256, NP / 256, 1, 0, G, bx};
            pg8::EpiInProj E{PO, IDX};
            pg8::gemm_phase<pg8::EpiInProj, true>(lds + RING_OFF, g, S, E);
        }
        if (IN(pb + 3) && (PHMASK & 8)) {
            pg8::Gemm g{Y, (const bf16_t*)(ws + WS_WBR + L * SZ_WBR), BW, 4096, BW, (size_t)BW * 2, (size_t)DM * BW * 2};
            pg8::Sched S{M / 256, DM / 256, 4, 1, G, bx};
            pg8::EpiMerge E{PO};
            pg8::gemm_phase<pg8::EpiMerge, true>(lds + RING_OFF, g, S, E);
        }
        if (IN(pb + 4) && (PHMASK & 16)) {
            pg8::Gemm g{PO + 4096, (const bf16_t*)(ws + WS_WOUT + L * SZ_WOUT), DM, NP, DM, 0, 0};
            pg8::Sched S{M / 256, DM / 256, 1, 0, G, bx};
            pg8::EpiOut E{L == 0 ? a.x : a.out, a.out};
            pg8::gemm_phase<pg8::EpiOut, true>(lds + RING_OFF, g, S, E);
        }
        if (IN(pb + 5) && (PHMASK & 32)) {
            const int gw = vcu * NWAVES + wave, NGW = G * NWAVES;
            if (L == 0) { for (int m = gw; m < M; m += NGW) rms_row<false>(a.out + (size_t)m * DM, a.ln_g + DM, XN + (size_t)m * DM, lane); }
            else { for (int m = gw; m < M; m += NGW) rms_row<true>(a.out + (size_t)m * DM, a.final_g, a.out + (size_t)m * DM, lane); }
        }
    }
#undef IN
}

__global__ void __launch_bounds__(128) k_kmean(const bf16_t* PO, float* kmean) {
    const int blk = blockIdx.x & 15, h = (blockIdx.x >> 4) & 7, b = blockIdx.x >> 7, d = threadIdx.x;
    const bf16_t* p = PO + (size_t)(b * SEQ + blk * 256) * NP + C_AK + h * 128 + d; float s = 0.f;
    for (int k = 0; k < 256; ++k) s += bf2f(p[(size_t)k * NP]);
    kmean[(size_t)blockIdx.x * 128 + d] = s * (1.0f / 256.0f);
}
__global__ void __launch_bounds__(256) k_conv(const bf16_t* PO, const float* cw, const float* cbias, bf16_t* Y) {
    const int t = blockIdx.x, pos = t & (SEQ - 1);
    for (int c = threadIdx.x; c < BW; c += 256) {
        const bf16_t* r0 = PO + (size_t)t * NP;
        const float u2 = bf2f(r0[C_CC + c]) * bf2f(r0[C_CH + c]);
        float u1 = 0.f, u0 = 0.f;
        if (pos >= 1) { const bf16_t* r1 = r0 - NP; u1 = bf2f(r1[C_CC + c]) * bf2f(r1[C_CH + c]); }
        if (pos >= 2) { const bf16_t* r2 = r0 - 2 * (size_t)NP; u0 = bf2f(r2[C_CC + c]) * bf2f(r2[C_CH + c]); }
        const float cv = cw[c] * u0 + cw[BW + c] * u1 + cw[2 * BW + c] * u2 + cbias[c];
        Y[(size_t)t * 4096 + 1024 + c] = (bf16_t)f2bf(bf2f(r0[C_CB + c]) * cv * bf2f(r0[C_CG + c]));
    }
}
__global__ void __launch_bounds__(256) k_topk_naive(const float* IDX, unsigned* maskw) {
    __shared__ float iq[256]; __shared__ float wj[4]; __shared__ float sc[SEQ];
    const int t = blockIdx.x, b = t >> 12, pos = t & (SEQ - 1), n = pos + 1, tid = threadIdx.x;
    iq[tid] = IDX[(size_t)t * 512 + tid];
    if (tid < 4) wj[tid] = IDX[(size_t)t * 512 + 320 + tid] * 0.0625f;
    __syncthreads();
    for (int s = tid; s < n; s += 256) {
        const float* ik = IDX + (size_t)(b * SEQ + s) * 512 + 256;
        float l0 = 0.f, l1 = 0.f, l2 = 0.f, l3 = 0.f;
        asm volatile("" ::: "memory");
#pragma unroll 8
        for (int i = 0; i < 64; ++i) { const float kv = ik[i]; l0 += iq[i] * kv; l1 += iq[64 + i] * kv; l2 += iq[128 + i] * kv; l3 += iq[192 + i] * kv; }
        float v = 0.f; v += wj[0] * fmaxf(l0, 0.f); v += wj[1] * fmaxf(l1, 0.f); v += wj[2] * fmaxf(l2, 0.f); v += wj[3] * fmaxf(l3, 0.f);
        sc[s] = v + 0.0f;
    }
    __syncthreads();
    for (int k = 0; k < 16; ++k) {
        const int s = tid + 256 * k; const float own = (s < n) ? sc[s] : 0.f; int rank = 0;
        if (n > 256 && s < n) { for (int s2 = 0; s2 < n; ++s2) { const float v = sc[s2]; rank += (v > own || (v == own && s2 < s)) ? 1 : 0; } }
        const bool sel = (s < n) && (n <= 256 || rank < 256);
        const unsigned long long bal = __ballot(sel);
        if ((tid & 63) == 0) { const int tile = 8 * k + 2 * (tid >> 6);
            maskw[((size_t)b * 128 + tile) * SEQ + pos] = (unsigned)bal; maskw[((size_t)b * 128 + tile + 1) * SEQ + pos] = (unsigned)(bal >> 32); }
    }
}
__device__ __forceinline__ float red32(float v) { v += __shfl_xor(v, 16); v += __shfl_xor(v, 8); v += __shfl_xor(v, 4); v += __shfl_xor(v, 2); v += __shfl_xor(v, 1); return v; }
__device__ __forceinline__ void ld4(const bf16_t* p, float (&o)[4]) { const u32x2 w = *(const u32x2*)p; o[0] = bflo(w.x); o[1] = bfhi(w.x); o[2] = bflo(w.y); o[3] = bfhi(w.y); }
struct OSm { float m, l, o[4]; };
__device__ __forceinline__ void osm_step(OSm& S, float s, const float (&v)[4]) {
    const float mn = fmaxf(S.m, s), al = __expf(S.m - mn), p = __expf(s - mn);
    S.l = S.l * al + p; S.o[0] = S.o[0] * al + p * v[0]; S.o[1] = S.o[1] * al + p * v[1]; S.o[2] = S.o[2] * al + p * v[2]; S.o[3] = S.o[3] * al + p * v[3]; S.m = mn;
}
__global__ void __launch_bounds__(256) k_dsa_naive(const bf16_t* PO, const unsigned* maskw, bf16_t* Y) {
    const int t = blockIdx.x, b = t >> 12, pos = t & (SEQ - 1), h = threadIdx.x >> 5, l = threadIdx.x & 31;
    float q[4]; ld4(PO + (size_t)t * NP + C_SQ + h * 128 + 4 * l, q);
    OSm S; S.m = -1e30f; S.l = 0.f; S.o[0] = S.o[1] = S.o[2] = S.o[3] = 0.f;
    const int ntile = (pos >> 5) + 1;
    for (int tile = 0; tile < ntile; ++tile) {
        unsigned w = maskw[((size_t)b * 128 + tile) * SEQ + pos];
        while (w) { const int bit = __builtin_ctz(w); w &= w - 1; const int key = tile * 32 + bit;
            const bf16_t* kr = PO + (size_t)(b * SEQ + key) * NP + h * 128 + 4 * l;
            float kk[4], vv[4]; ld4(kr + C_SK, kk); ld4(kr + C_SV, vv);
            const float s = red32(q[0] * kk[0] + q[1] * kk[1] + q[2] * kk[2] + q[3] * kk[3]) * 0.08838834764831845f;
            osm_step(S, s, vv); }
    }
    float g[4]; ld4(PO + (size_t)t * NP + C_SG + h * 128 + 4 * l, g);
    const float il = 1.0f / S.l;
    *(u32x2*)(Y + (size_t)t * 4096 + 2048 + h * 128 + 4 * l) = (u32x2){pk2(S.o[0] * il * g[0], S.o[1] * il * g[1]), pk2(S.o[2] * il * g[2], S.o[3] * il * g[3])};
}
__global__ void __launch_bounds__(256) k_moba_naive(const bf16_t* PO, const float* kmean, bf16_t* Y) {
    const int t = blockIdx.x, b = t >> 12, pos = t & (SEQ - 1), h = threadIdx.x >> 5, l = threadIdx.x & 31, qblk = pos >> 8;
    float q[4]; ld4(PO + (size_t)t * NP + C_AQ + h * 128 + 4 * l, q);
    unsigned chosen = 0;
    if (qblk <= 3) chosen = (1u << qblk) - 1u;
    else {
        float bs[16];
#pragma unroll
        for (int nn = 0; nn < 16; ++nn) { bs[nn] = -INFINITY;
            if (nn < qblk) { const f32x4 km = *(const f32x4*)(kmean + ((size_t)((b * 8 + h) * 16 + nn)) * 128 + 4 * l); bs[nn] = red32(q[0] * km.x + q[1] * km.y + q[2] * km.z + q[3] * km.w); } }
        for (int r = 0; r < 3; ++r) { float best = -INFINITY; int bi = -1;
#pragma unroll
            for (int nn = 0; nn < 16; ++nn) if (nn < qblk && !((chosen >> nn) & 1u) && (bi < 0 || bs[nn] > best)) { best = bs[nn]; bi = nn; }
            chosen |= 1u << bi; }
    }
    OSm S; S.m = -1e30f; S.l = 0.f; S.o[0] = S.o[1] = S.o[2] = S.o[3] = 0.f;
    for (int blk = 0; blk <= qblk; ++blk) {
        if (blk < qblk && !((chosen >> blk) & 1u)) continue;
        const int kend = (blk == qblk) ? (pos & 255) : 255;
        for (int k = 0; k <= kend; ++k) { const bf16_t* kr = PO + (size_t)(b * SEQ + blk * 256 + k) * NP + h * 128 + 4 * l;
            float kk[4], vv[4]; ld4(kr + C_AK, kk); ld4(kr + C_AV, vv);
            const float s = red32(q[0] * kk[0] + q[1] * kk[1] + q[2] * kk[2] + q[3] * kk[3]) * 0.08838834764831845f;
            osm_step(S, s, vv); }
    }
    float g[4]; ld4(PO + (size_t)t * NP + C_AG + h * 128 + 4 * l, g);
    const float il = 1.0f / S.l;
    *(u32x2*)(Y + (size_t)t * 4096 + h * 128 + 4 * l) = (u32x2){pk2(S.o[0] * il * g[0], S.o[1] * il * g[1]), pk2(S.o[2] * il * g[2], S.o[3] * il * g[3])};
}
__global__ void __launch_bounds__(256) k_mem_naive(const bf16_t* PO, const bf16_t* KVM, bf16_t* Y) {
    const int t = blockIdx.x, b = t >> 12, h = threadIdx.x >> 6, l = threadIdx.x & 63;
    float q[4]; ld4(PO + (size_t)t * NP + C_MQ + h * 256 + 4 * l, q);
    OSm S; S.m = -1e30f; S.l = 0.f; S.o[0] = S.o[1] = S.o[2] = S.o[3] = 0.f;
    for (int m = 0; m < MEML; ++m) { const bf16_t* kr = KVM + (size_t)(b * MEML + m) * 2048 + h * 256 + 4 * l;
        float kk[4], vv[4]; ld4(kr, kk); ld4(kr + 1024, vv);
        const float s = wave_sum(q[0] * kk[0] + q[1] * kk[1] + q[2] * kk[2] + q[3] * kk[3]) * 0.0625f;
        osm_step(S, s, vv); }
    float g[4]; ld4(PO + (size_t)t * NP + C_MG + h * 256 + 4 * l, g);
    const float il = 1.0f / S.l;
    *(u32x2*)(Y + (size_t)t * 4096 + 3072 + h * 256 + 4 * l) = (u32x2){pk2(S.o[0] * il * g[0], S.o[1] * il * g[1]), pk2(S.o[2] * il * g[2], S.o[3] * il * g[3])};
}

extern "C" void kernel_launch(void* const* d_in, const int* in_sizes, int n_in, void* d_out, int out_size, void* d_ws, size_t ws_size, hipStream_t stream) {
    static int grid = 0;
    if (grid == 0) {
        if (n_in != 11 || out_size != M * DM || ws_size < WS_END) { fprintf(stderr, "kernel_launch: unexpected shapes (n_in %d out %d ws %zu need %zu)\n", n_in, out_size, ws_size, (size_t)WS_END); grid = -1; return; }
        int dev = 0, cus = 0;
        if (hipGetDevice(&dev) != hipSuccess || hipDeviceGetAttribute(&cus, hipDeviceAttributeMultiprocessorCount, dev) != hipSuccess) { grid = -1; return; }
        if (hipFuncSetAttribute((const void*)fwd, hipFuncAttributeMaxDynamicSharedMemorySize, LDS_BYTES) != hipSuccess) { fprintf(stderr, "kernel_launch: hipFuncSetAttribute failed\n"); grid = -1; return; }
        grid = cus;
    }
    if (grid < 0) return;
    Args a{};
    a.x = (const float*)d_in[0]; a.mem = (const float*)d_in[1]; a.ln_g = (const float*)d_in[2]; a.w_in = (const float*)d_in[3]; a.conv_w = (const float*)d_in[4]; a.conv_b = (const float*)d_in[5];
    a.mem_ln_g = (const float*)d_in[6]; a.w_mem_kv = (const float*)d_in[7]; a.w_branch = (const float*)d_in[8]; a.w_out = (const float*)d_in[9]; a.final_g = (const float*)d_in[10];
    a.out = (float*)d_out; a.ws = (unsigned char*)d_ws;
    unsigned char* ws = (unsigned char*)d_ws;
    const bf16_t* PO = (const bf16_t*)(ws + WS_PO); bf16_t* Y = (bf16_t*)(ws + WS_Y); float* IDX = (float*)(ws + WS_IDX);
    unsigned* maskw = (unsigned*)(ws + WS_MASK); float* kmean = (float*)(ws + WS_KMEAN);
    auto run = [&](int lo, int hi) { a.ph_lo = lo; a.ph_hi = hi; hipLaunchKernelGGL(fwd, dim3(grid), dim3(NWAVES * 64), LDS_BYTES, stream, a); };
    run(0, 1); run(1, 2);
    for (int L = 0; L < 2; ++L) {
        const int pb = 2 + 6 * L;
        run(pb, pb + 1);
        hipLaunchKernelGGL(k_kmean, dim3(512), dim3(128), 0, stream, PO, kmean);
        hipLaunchKernelGGL(k_conv, dim3(M), dim3(256), 0, stream, PO, a.conv_w + (size_t)L * 3 * BW, a.conv_b + (size_t)L * BW, Y);
        hipLaunchKernelGGL(k_topk_naive, dim3(M), dim3(256), 0, stream, (const float*)IDX, maskw);
        hipLaunchKernelGGL(k_mem_naive, dim3(M), dim3(256), 0, stream, PO, (const bf16_t*)(ws + WS_KVM) + (size_t)L * 1024 * 2048, Y);
        hipLaunchKernelGGL(k_moba_naive, dim3(M), dim3(256), 0, stream, PO, (const float*)kmean, Y);
        hipLaunchKernelGGL(k_dsa_naive, dim3(M), dim3(256), 0, stream, PO, (const unsigned*)maskw, Y);
        run(pb + 3, pb + 4); run(pb + 4, pb + 5); run(pb + 5, pb + 6);
    }
    const hipError_t le = hipPeekAtLastError();
    if (le != hipSuccess) fprintf(stderr, "kernel_launch: launch failed: %s\n", hipGetErrorName(le));
}
```

```cpp
#include <hip/hip_runtime.h>
#include <cstdio>
#include <cstdint>

#define LAS __attribute__((address_space(3)))
#define GAS __attribute__((address_space(1)))
typedef unsigned short bf16_t;
typedef short bf16x8 __attribute__((ext_vector_type(8)));
typedef float f32x4 __attribute__((ext_vector_type(4)));
typedef float f32x2 __attribute__((ext_vector_type(2)));
typedef unsigned u32x4 __attribute__((ext_vector_type(4)));
typedef unsigned u32x2 __attribute__((ext_vector_type(2)));
typedef int i32x4 __attribute__((ext_vector_type(4)));
typedef int i32x8 __attribute__((ext_vector_type(8)));

constexpr int DM = 2048, NB = 4, SEQ = 4096, M = NB * SEQ, MEML = 256, BW = 1024;
constexpr int NIN = 22852, NP = 23040, NPO = 14848;
constexpr float EPS = 1e-6f;
constexpr int BF_LO = 16, BF_HI = 16, NBC = BF_HI - BF_LO, NBF = NBC + 2, NI8 = 90 - NBF;
__host__ __device__ constexpr int i8_tile(int i) { return i < BF_LO ? i : (i + NBC < 56 ? i + NBC : i + NBC + 2); }
__host__ __device__ constexpr int bf_tile(int i) { return i < NBC ? BF_LO + i : 56 + (i - NBC); }
constexpr int XNP = 2112, YB = 5248, WKP = 2112, WBP = 1088;
constexpr int C_AQ = 0, C_AK = 1024, C_AV = 2048, C_AG = 3072, C_CB = 4096, C_CC = 5120, C_CH = 6144, C_CG = 7168;
constexpr int C_SQ = 8192, C_SK = 9216, C_SV = 10240, C_SG = 11264, C_MQ = 12288, C_MG = 13312, C_IDX = 14336, C_R = 14848;
constexpr size_t MiB = 1u << 20;
constexpr size_t WS_CTL = 0, CTL_BYTES = 1 * MiB;
constexpr size_t SZ_WIN = (size_t)NP * WKP * 2, SZ_WKV = (size_t)2048 * WKP * 2, SZ_WBR = (size_t)4 * DM * WBP * 2, SZ_WOUT = (size_t)DM * WKP * 2;
constexpr size_t WS_WIN = 1 * MiB;
constexpr size_t WS_WKV = WS_WIN + 2 * SZ_WIN;
constexpr size_t WS_WBR = WS_WKV + 2 * SZ_WKV;
constexpr size_t WS_WOUT = WS_WBR + 2 * SZ_WBR;
constexpr size_t WS_XN = WS_WOUT + 2 * SZ_WOUT;
constexpr size_t WS_MEMN = WS_XN + (size_t)M * XNP * 2;
constexpr size_t WS_KVM = WS_MEMN + 2 * (size_t)1024 * WKP * 2;
constexpr size_t WS_PO = WS_KVM + 2 * (size_t)1024 * 2048 * 2;
constexpr size_t WS_IDX = WS_PO + (size_t)M * NPO * 2;
constexpr size_t WS_Y = WS_IDX + (size_t)M * 4 * 4;
constexpr size_t WS_MASK = WS_Y + (size_t)M * YB;
constexpr size_t WS_KMEAN = WS_MASK + (size_t)4 * 128 * 4096 * 4;
constexpr size_t WS_PM = WS_KMEAN + (size_t)4 * 8 * 16 * 128 * 4;
constexpr size_t WS_SCR = WS_PM + (size_t)M * 1024 * 2;
constexpr size_t WS_IQC = WS_SCR + (size_t)256 * 512 * 1024;
constexpr size_t WS_IKC = WS_IQC + (size_t)M * 256 * 2;
constexpr size_t WS_G8 = WS_IKC + (size_t)M * 64 * 2;
constexpr int XN8P = 2176, W8P = 2176;
constexpr size_t WS_XN8 = WS_G8 + (size_t)M * 8192;
constexpr size_t WS_SA = WS_XN8 + (size_t)M * XN8P;
constexpr size_t WS_W8 = WS_SA + (size_t)M * 4;
constexpr size_t SZ_W8 = (size_t)NP * W8P;
constexpr size_t WS_SB = WS_W8 + 2 * SZ_W8;
constexpr size_t WS_WB8 = WS_SB + 2 * (size_t)NP * 4;
constexpr size_t SZ_WB8 = (size_t)3 * DM * WBP * 2;
constexpr size_t WS_END = WS_WB8 + 2 * SZ_WB8;
constexpr float YSC = 8.0f, WSC = 32.0f;
constexpr size_t WS_MASK2 = WS_END;
constexpr size_t WS_MK = WS_KVM, WS_VT = WS_KVM + 4 * MiB;

__device__ __forceinline__ unsigned f2bf(float f) { unsigned u = __builtin_bit_cast(unsigned, f); return (u + 0x7fffu + ((u >> 16) & 1u)) >> 16; }
__device__ __forceinline__ unsigned pk2(float lo, float hi) { unsigned r; asm("v_cvt_pk_bf16_f32 %0, %1, %2" : "=v"(r) : "v"(lo), "v"(hi)); return r; }
__device__ __forceinline__ unsigned pk4f8(float a, float b, float c, float d) { unsigned w = 0u; w = __builtin_amdgcn_cvt_pk_fp8_f32(a, b, w, false); w = __builtin_amdgcn_cvt_pk_fp8_f32(c, d, w, true); return w; }
__device__ __forceinline__ float bf2f(unsigned short h) { return __builtin_bit_cast(float, (unsigned)h << 16); }
__device__ __forceinline__ float bflo(unsigned w) { return __builtin_bit_cast(float, w << 16); }
__device__ __forceinline__ float bfhi(unsigned w) { return __builtin_bit_cast(float, w & 0xffff0000u); }
__device__ __forceinline__ float relu_i(float x) { const int b = __builtin_bit_cast(int, x); return __builtin_bit_cast(float, b > 0 ? b : 0); }
__device__ __forceinline__ float sigmoidf_(float x) { return __builtin_amdgcn_rcpf(1.0f + __builtin_amdgcn_exp2f(x * -1.4426950408889634f)); }
__device__ __forceinline__ float siluf_(float x) { return x * __builtin_amdgcn_rcpf(1.0f + __builtin_amdgcn_exp2f(x * -1.4426950408889634f)); }

__device__ __forceinline__ int lane_id_v() { int l; asm volatile("v_mbcnt_lo_u32_b32 %0, -1, 0\n\tv_mbcnt_hi_u32_b32 %0, -1, %0" : "=v"(l)); return l; }
__device__ __forceinline__ int lane_id() { return (int)__builtin_amdgcn_mbcnt_hi(~0u, __builtin_amdgcn_mbcnt_lo(~0u, 0u)); }
__device__ __forceinline__ float xor32_max(float v) { return fmaxf(v, __shfl_xor(v, 32)); }
__device__ __forceinline__ float xor32_sum(float v) { return v + __shfl_xor(v, 32); }
__device__ __forceinline__ float xor16f(float v) { return __builtin_bit_cast(float, __builtin_amdgcn_ds_swizzle(__builtin_bit_cast(int, v), 0x401F)); }

namespace pg8 {
constexpr int BM = 256, BK = 64, HALF = 128, HTB = HALF * BK * 2, STAGE_BYTES = 8 * HTB, NXCD = 8, WGM = 8;
__host__ __device__ __forceinline__ int lds_byte(int r, int c) { const int st = (r >> 4) * 2 + (c >> 5), rr = r & 15, cc = c & 31, ob = rr * 64 + cc * 2; return st * 1024 + (ob ^ (((ob >> 9) & 1) << 5)); }
__host__ __device__ __forceinline__ void stage_rc(int b, int& R, int& C) { const int st = b / 1024, sb = b % 1024, swz = sb ^ (((sb >> 9) & 1) << 5); R = (st >> 1) * 16 + swz / 64; C = (st & 1) * 32 + (swz % 64) / 2; }
__host__ __device__ __forceinline__ int perm32(int rho) { const int n = rho >> 4, i = rho & 15; return 8 * (i >> 2) + 4 * n + (i & 3); }

struct Unit { int pm, pn, z, par; };
struct Gemm { const bf16_t* A; const bf16_t* Bt; int K, lda, ldb; size_t azs, bzs, bbs; };

struct Sched {
    int nM, nN, nZ, zinner, G, c, pmap, skew;
    __device__ __forceinline__ bool next(int i, Unit& u) const {
        const int nwg = nM * nN; long L; int zi;
        if (zinner) { zi = i % nZ; L = (long)(i / nZ) * G + c; if (L >= nwg) return false; }
        else { L = (long)i * G + c;
            if (skew && i >= skew) { if (c < 128 || i >= skew + 2) return false; L = (long)skew * G + (i - skew) * 128 + (c - 128); }
            if (L >= (long)nwg * nZ) return false; zi = (int)(L / nwg); L = L % nwg; }
        int wgid = (int)L; { const int q = nwg / NXCD, r = nwg % NXCD, xcd = wgid % NXCD, off = wgid / NXCD; wgid = (xcd < r ? xcd * (q + 1) : r * (q + 1) + (xcd - r) * q) + off; }
        const int nig = WGM * nN, gid = wgid / nig, fm = gid * WGM, gsz = (nM - fm) < WGM ? (nM - fm) : WGM;
        u.pm = fm + ((wgid % nig) % gsz); u.pn = (wgid % nig) / gsz; u.z = zi;
        if (pmap == 1) u.pn = i8_tile(u.pn);
        else if (pmap == 2) u.pn = bf_tile(u.pn);
        return true;
    }
};

template <bool I8>
struct EpiInProj { static __device__ __forceinline__ bool keep(const Unit&) { return false; } static constexpr int ID = 1;
    static constexpr bool PERM = true;
    __device__ __forceinline__ void prefetch(const Unit& u, int wid, int lane) const {
        if constexpr (I8) { const float* gp = (wid < 4) ? SA + u.pm * BM + 64 * wid + lane : SB + u.pn * BM + 64 * (wid - 4) + lane;
            __builtin_amdgcn_global_load_lds((const unsigned*)gp, (LAS unsigned*)(scb + u.par * 512 + wid * 64), 4, 0, 0); } }
    bf16_t* PO; float* IDX; bf16_t* IQC; bf16_t* IKC; unsigned char* G8; const float* SA; const float* SB; const LAS unsigned char* lut; LAS float* scb;
    __device__ __forceinline__ void operator()(f32x4 (&acc)[2][2][4][2], const Unit& u, int wr, int wc, int fr, int fq) const {
        const int pn = u.pn;
        const int row0 = u.pm * BM + wr * 64 + fr;
        if constexpr (I8) {
            float sa[2][4]; f32x4 sb[2][2];
            const LAS float* sc = scb + u.par * 512;
#pragma unroll
            for (int ai = 0; ai < 2; ++ai)
#pragma unroll
                for (int m = 0; m < 4; ++m) sa[ai][m] = sc[ai * HALF + wr * 64 + m * 16 + fr];
#pragma unroll
            for (int bj = 0; bj < 2; ++bj) { sb[bj][0] = *(const LAS f32x4*)(sc + 256 + bj * HALF + wc * 32 + 8 * fq); sb[bj][1] = *(const LAS f32x4*)(sc + 256 + bj * HALF + wc * 32 + 8 * fq + 4); }
            if (pn >= 58) {
                const int col0 = (pn - 58) * BM + wc * 32 + 8 * fq;
                unsigned gofs = (unsigned)row0 * 8192u + (unsigned)col0; asm volatile("" : "+v"(gofs));
#pragma unroll
                for (int ai = 0; ai < 2; ++ai)
#pragma unroll
                    for (int m = 0; m < 4; ++m) { unsigned char* rowp = G8 + (gofs + (unsigned)(ai * HALF + m * 16) * 8192u); const float s256 = sa[ai][m] * 256.0f;
                        unsigned q[2][8];
#pragma unroll
                        for (int bj = 0; bj < 2; ++bj)
#pragma unroll
                            for (int n = 0; n < 2; ++n) { i32x4 iv = __builtin_bit_cast(i32x4, acc[ai][bj][m][n]); asm volatile("" : "+v"(iv));
                                const f32x4 fv = __builtin_convertvector(iv, f32x4) * sb[bj][n];
#pragma unroll
                                for (int e = 0; e < 4; ++e) { const float t = __builtin_amdgcn_fmed3f(fmaf(fv[e], s256, 2048.5f), 0.5f, 4095.5f); q[bj][4 * n + e] = lut[(unsigned)t]; } }
#pragma unroll
                        for (int bj = 0; bj < 2; ++bj) *(u32x2*)(rowp + bj * HALF) = (u32x2){q[bj][0] | (q[bj][1] << 8) | (q[bj][2] << 16) | (q[bj][3] << 24), q[bj][4] | (q[bj][5] << 8) | (q[bj][6] << 16) | (q[bj][7] << 24)};
                        if (m & 1) __builtin_amdgcn_sched_barrier(0); }
                return;
            }
#pragma unroll
            for (int ai = 0; ai < 2; ++ai)
#pragma unroll
                for (int bj = 0; bj < 2; ++bj)
#pragma unroll
                    for (int m = 0; m < 4; ++m)
#pragma unroll
                        for (int n = 0; n < 2; ++n) { const i32x4 iv = __builtin_bit_cast(i32x4, acc[ai][bj][m][n]); acc[ai][bj][m][n] = __builtin_convertvector(iv, f32x4) * (sb[bj][n] * sa[ai][m]); }
        }
        const int act = ((pn >= 12 && pn < 16) || (pn >= 28 && pn < 32) || (pn >= 44 && pn < 48) || (pn >= 52 && pn < 56)) ? 1 : 0;
        const int col0 = pn * BM + wc * 32 + 8 * fq;
        int row0n = row0; asm volatile("" : "+v"(row0n));
#pragma unroll
        for (int ai = 0; ai < 2; ++ai)
#pragma unroll
            for (int m = 0; m < 4; ++m) { const int row = row0n + ai * HALF + m * 16; bf16_t* rowp = PO + (size_t)row * NPO + col0;
#pragma unroll
                for (int bj = 0; bj < 2; ++bj) { f32x4 v0 = acc[ai][bj][m][0], v1 = acc[ai][bj][m][1];
                    if (act == 1) { v0 = (f32x4){siluf_(v0[0]), siluf_(v0[1]), siluf_(v0[2]), siluf_(v0[3])}; v1 = (f32x4){siluf_(v1[0]), siluf_(v1[1]), siluf_(v1[2]), siluf_(v1[3])}; }
                    u32x4 w; w.x = pk2(v0[0], v0[1]); w.y = pk2(v0[2], v0[3]); w.z = pk2(v1[0], v1[1]); w.w = pk2(v1[2], v1[3]);
                    *(u32x4*)(rowp + bj * HALF) = w;
                    if (pn == 56 || pn == 57) { const int ic = wc * 32 + 8 * fq + bj * HALF;
                        if (pn == 56) *(u32x4*)(IQC + (size_t)row * 256 + ic) = w; else if (ic < 64) *(u32x4*)(IKC + (size_t)row * 64 + ic) = w; else if (ic == 64) *(f32x4*)(IDX + (size_t)row * 4) = v0; }
                } }
    }
};
struct EpiBf16 { static __device__ __forceinline__ bool keep(const Unit&) { return false; } static constexpr int ID = 2;
    static constexpr bool PERM = true;
    bf16_t* O; int ldc; size_t zstride;
    __device__ __forceinline__ void operator()(f32x4 (&acc)[2][2][4][2], const Unit& u, int wr, int wc, int fr, int fq) const {
        const int row0 = u.pm * BM + wr * 64 + fr, col0 = u.pn * BM + wc * 32 + 8 * fq; bf16_t* base = O + (size_t)u.z * zstride;
#pragma unroll
        for (int ai = 0; ai < 2; ++ai)
#pragma unroll
            for (int m = 0; m < 4; ++m) { bf16_t* rowp = base + (size_t)(row0 + ai * HALF + m * 16) * ldc + col0;
#pragma unroll
                for (int bj = 0; bj < 2; ++bj) { const f32x4 v0 = acc[ai][bj][m][0], v1 = acc[ai][bj][m][1];
                    u32x4 w; w.x = pk2(v0[0], v0[1]); w.y = pk2(v0[2], v0[3]); w.z = pk2(v1[0], v1[1]); w.w = pk2(v1[2], v1[3]);
                    *(u32x4*)(rowp + bj * HALF) = w; } }
    }
};
__device__ __forceinline__ void unpack8(const u32x2 g, float (&f)[8]) {
    f[0] = (float)(g.x & 0xffu); f[1] = (float)((g.x >> 8) & 0xffu); f[2] = (float)((g.x >> 16) & 0xffu); f[3] = (float)(g.x >> 24);
    f[4] = (float)(g.y & 0xffu); f[5] = (float)((g.y >> 8) & 0xffu); f[6] = (float)((g.y >> 16) & 0xffu); f[7] = (float)(g.y >> 24); }
struct EpiMergeC { static constexpr int ID = 7; static constexpr bool PERM = true;
    bf16_t* PO; const unsigned char* G8;
    static __device__ __forceinline__ bool keep(const Unit&) { return false; }
    __device__ __forceinline__ void operator()(f32x4 (&acc)[2][2][4][2], const Unit& u, int wr, int wc, int fr, int fq) const {
        const int row0 = u.pm * BM + wr * 64 + fr, col0 = u.pn * BM + wc * 32 + 8 * fq;
        u32x2 ga[2][4][2];
#pragma unroll
        for (int ai = 0; ai < 2; ++ai)
#pragma unroll
            for (int m = 0; m < 4; ++m) { const unsigned char* grow = G8 + (size_t)(row0 + ai * HALF + m * 16) * 8192 + 2048 + col0;
#pragma unroll
                for (int bj = 0; bj < 2; ++bj) ga[ai][m][bj] = *(const u32x2*)(grow + bj * HALF); }
#pragma unroll
        for (int ai = 0; ai < 2; ++ai)
#pragma unroll
            for (int m = 0; m < 4; ++m) { const size_t row = (size_t)(row0 + ai * HALF + m * 16);
#pragma unroll
                for (int bj = 0; bj < 2; ++bj) { const int c = col0 + bj * HALF;
                    float f[8]; unpack8(ga[ai][m][bj], f);
                    const f32x4 v0 = acc[ai][bj][m][0] * (1.0f / 255.0f), v1 = acc[ai][bj][m][1] * (1.0f / 255.0f);
                    u32x4 w; w.x = pk2(v0[0] * f[0], v0[1] * f[1]); w.y = pk2(v0[2] * f[2], v0[3] * f[3]); w.z = pk2(v1[0] * f[4], v1[1] * f[5]); w.w = pk2(v1[2] * f[6], v1[3] * f[7]);
                    *(u32x4*)(PO + row * NPO + 4096 + c) = w; } }
    }
};
struct EpiMerge { static constexpr int ID = 3; static constexpr bool PERM = true;
    bf16_t* PO; const unsigned char* G8;
    static __device__ __forceinline__ bool keep(const Unit& u) { return u.z < 2; }
    __device__ __forceinline__ void operator()(f32x4 (&acc)[2][2][4][2], const Unit& u, int wr, int wc, int fr, int fq) const {
        const int row0 = u.pm * BM + wr * 64 + fr, col0 = u.pn * BM + wc * 32 + 8 * fq; const int z = u.z;
        if (z < 2) {
            const int oa = (z == 0 ? 0 : 2) * 2048, ob = (z == 0 ? 2 : 3) * 2048;
            u32x2 ga[2][4][2], gb[2][4][2];
#pragma unroll
            for (int ai = 0; ai < 2; ++ai)
#pragma unroll
                for (int m = 0; m < 4; ++m) { const unsigned char* grow = G8 + (size_t)(row0 + ai * HALF + m * 16) * 8192 + col0;
#pragma unroll
                    for (int bj = 0; bj < 2; ++bj) { ga[ai][m][bj] = *(const u32x2*)(grow + oa + bj * HALF); gb[ai][m][bj] = *(const u32x2*)(grow + ob + bj * HALF); } }
#pragma unroll
            for (int ai = 0; ai < 2; ++ai)
#pragma unroll
                for (int m = 0; m < 4; ++m)
#pragma unroll
                    for (int bj = 0; bj < 2; ++bj) { float f[8], h[8]; unpack8(ga[ai][m][bj], f); unpack8(gb[ai][m][bj], h);
#pragma unroll
                        for (int i = 0; i < 8; ++i) f[i] = fmaxf(f[i], 1e-30f) * __builtin_amdgcn_rcpf(fmaxf(h[i], 1e-30f));
                        const f32x4 v0 = acc[ai][bj][m][0], v1 = acc[ai][bj][m][1];
                        acc[ai][bj][m][0] = (f32x4){v0[0] * f[0], v0[1] * f[1], v0[2] * f[2], v0[3] * f[3]}; acc[ai][bj][m][1] = (f32x4){v1[0] * f[4], v1[1] * f[5], v1[2] * f[6], v1[3] * f[7]}; }
        } else {
            constexpr float S = 1.0f / (255.0f * YSC * WSC);
#pragma unroll
            for (int ai = 0; ai < 2; ++ai) {
                u32x2 ga[4][2]; u32x4 pp[4][2];
#pragma unroll
                for (int m = 0; m < 4; ++m) { const size_t row = (size_t)(row0 + ai * HALF + m * 16);
#pragma unroll
                    for (int bj = 0; bj < 2; ++bj) { ga[m][bj] = *(const u32x2*)(G8 + row * 8192 + 3 * 2048 + col0 + bj * HALF); pp[m][bj] = *(const u32x4*)(PO + row * NPO + 4096 + col0 + bj * HALF); } }
                asm volatile("" ::: "memory");
#pragma unroll
                for (int m = 0; m < 4; ++m) { const size_t row = (size_t)(row0 + ai * HALF + m * 16);
#pragma unroll
                    for (int bj = 0; bj < 2; ++bj) { float f[8]; unpack8(ga[m][bj], f); const u32x4 p = pp[m][bj];
                        const f32x4 v0 = acc[ai][bj][m][0] * S, v1 = acc[ai][bj][m][1] * S;
                        u32x4 w; w.x = pk2(fmaf(v0[0], f[0], bflo(p.x)), fmaf(v0[1], f[1], bfhi(p.x))); w.y = pk2(fmaf(v0[2], f[2], bflo(p.y)), fmaf(v0[3], f[3], bfhi(p.y)));
                        w.z = pk2(fmaf(v1[0], f[4], bflo(p.z)), fmaf(v1[1], f[5], bfhi(p.z))); w.w = pk2(fmaf(v1[2], f[6], bflo(p.w)), fmaf(v1[3], f[7], bfhi(p.w)));
                        *(u32x4*)(PO + row * NPO + 4096 + col0 + bj * HALF) = w; } }
                asm volatile("" ::: "memory");
            }
        }
    }
};
struct EpiOut { static __device__ __forceinline__ bool keep(const Unit&) { return false; } static constexpr int ID = 4;
    static constexpr bool PERM = true;
    const float* resid; float* out;
    __device__ __forceinline__ void operator()(f32x4 (&acc)[2][2][4][2], const Unit& u, int wr, int wc, int fr, int fq) const {
        const int row0 = u.pm * BM + wr * 64 + fr, col0 = u.pn * BM + wc * 32 + 8 * fq;
#if defined(PROBE_EPI) && PROBE_EPI == 4
        for (int rep2 = 0; rep2 < ((resid != out) ? 2 : 1); ++rep2)
#endif
#pragma unroll
        for (int ai = 0; ai < 2; ++ai) {
            f32x4 r[4][2][2];
#pragma unroll
            for (int m = 0; m < 4; ++m) { const float* rp = resid + (size_t)(row0 + ai * HALF + m * 16) * DM + col0;
#pragma unroll
                for (int bj = 0; bj < 2; ++bj) { r[m][bj][0] = *(const f32x4*)(rp + bj * HALF); r[m][bj][1] = *(const f32x4*)(rp + bj * HALF + 4); } }
            asm volatile("" ::: "memory");
#pragma unroll
            for (int m = 0; m < 4; ++m) { float* op = out + (size_t)(row0 + ai * HALF + m * 16) * DM + col0;
#pragma unroll
                for (int bj = 0; bj < 2; ++bj) { *(f32x4*)(op + bj * HALF) = acc[ai][bj][m][0] + r[m][bj][0]; *(f32x4*)(op + bj * HALF + 4) = acc[ai][bj][m][1] + r[m][bj][1]; } }
            asm volatile("" ::: "memory");
        }
    }
};

struct EpiSoftmax { static __device__ __forceinline__ bool keep(const Unit&) { return false; } static constexpr int ID = 5;
    static constexpr bool PERM = true;
    bf16_t* PM; LAS float* xl;
    __device__ __forceinline__ void operator()(f32x4 (&acc)[2][2][4][2], const Unit& u, int wr, int wc, int fr, int fq) const {
        constexpr float C = 0.0625f * 1.4426950408889634f;
        int rb_ = (wr * 64 + fr) * 4; asm volatile("" : "+v"(rb_));
        LAS float* Pm = xl + rb_; LAS float* Ps = xl + 1024 + rb_;
#pragma unroll
        for (int ai = 0; ai < 2; ++ai)
#pragma unroll
            for (int m = 0; m < 4; ++m) { float mx = -INFINITY;
#pragma unroll
                for (int bj = 0; bj < 2; ++bj)
#pragma unroll
                    for (int n = 0; n < 2; ++n) { const f32x4 x = acc[ai][bj][m][n]; mx = fmaxf(mx, fmaxf(fmaxf(x[0], x[1]), fmaxf(x[2], x[3]))); }
                mx = fmaxf(mx, xor16f(mx)); mx = xor32_max(mx);
                if (fq == 0) Pm[(ai * HALF + m * 16) * 4 + wc] = mx; }
        asm volatile("s_waitcnt lgkmcnt(0)" ::: "memory"); __builtin_amdgcn_s_barrier(); asm volatile("" ::: "memory");
#pragma unroll
        for (int ai = 0; ai < 2; ++ai)
#pragma unroll
            for (int m = 0; m < 4; ++m) { const int row = ai * HALF + m * 16; const f32x4 pm4 = *(const LAS f32x4*)(Pm + row * 4);
                const float mm = fmaxf(fmaxf(pm4[0], pm4[1]), fmaxf(pm4[2], pm4[3])) * C; float sm = 0.f;
#pragma unroll
                for (int bj = 0; bj < 2; ++bj)
#pragma unroll
                    for (int n = 0; n < 2; ++n) { f32x4 x = acc[ai][bj][m][n];
                        x = (f32x4){__builtin_amdgcn_exp2f(fmaf(x[0], C, -mm)), __builtin_amdgcn_exp2f(fmaf(x[1], C, -mm)), __builtin_amdgcn_exp2f(fmaf(x[2], C, -mm)), __builtin_amdgcn_exp2f(fmaf(x[3], C, -mm))};
                        acc[ai][bj][m][n] = x; sm += (x[0] + x[1]) + (x[2] + x[3]); }
                sm += xor16f(sm); sm = xor32_sum(sm);
                if (fq == 0) Ps[row * 4 + wc] = sm; }
        asm volatile("s_waitcnt lgkmcnt(0)" ::: "memory"); __builtin_amdgcn_s_barrier(); asm volatile("" ::: "memory");
        const int row0 = u.pm * BM + wr * 64 + fr, col0 = u.z * 256 + wc * 32 + 8 * fq;
#pragma unroll
        for (int ai = 0; ai < 2; ++ai)
#pragma unroll
            for (int m = 0; m < 4; ++m) { const int row = ai * HALF + m * 16; const f32x4 ps4 = *(const LAS f32x4*)(Ps + row * 4);
                const float inv = 1.0f / ((ps4[0] + ps4[1]) + (ps4[2] + ps4[3])); bf16_t* rowp = PM + (size_t)(row0 + ai * HALF + m * 16) * 1024 + col0;
#pragma unroll
                for (int bj = 0; bj < 2; ++bj) { const f32x4 v0 = acc[ai][bj][m][0] * inv, v1 = acc[ai][bj][m][1] * inv;
                    u32x4 w; w.x = pk2(v0[0], v0[1]); w.y = pk2(v0[2], v0[3]); w.z = pk2(v1[0], v1[1]); w.w = pk2(v1[2], v1[3]);
                    *(u32x4*)(rowp + bj * HALF) = w; } }
        asm volatile("s_waitcnt lgkmcnt(0)" ::: "memory"); __builtin_amdgcn_s_barrier(); asm volatile("" ::: "memory");
    }
};
struct EpiMemOut { static __device__ __forceinline__ bool keep(const Unit&) { return false; } static constexpr int ID = 6;
    static constexpr bool PERM = true;
    const bf16_t* PO; unsigned char* Y;
    __device__ __forceinline__ void operator()(f32x4 (&acc)[2][2][4][2], const Unit& u, int wr, int wc, int fr, int fq) const {
        const int row0 = u.pm * BM + wr * 64 + fr, col0 = u.z * 256 + wc * 32 + 8 * fq;
        u32x4 gg[2][4][2];
#pragma unroll
        for (int ai = 0; ai < 2; ++ai)
#pragma unroll
            for (int m = 0; m < 4; ++m)
#pragma unroll
                for (int bj = 0; bj < 2; ++bj) gg[ai][m][bj] = *(const u32x4*)(PO + (size_t)(row0 + ai * HALF + m * 16) * NPO + C_MG + col0 + bj * HALF);
        asm volatile("" ::: "memory");
#pragma unroll
        for (int ai = 0; ai < 2; ++ai)
#pragma unroll
            for (int m = 0; m < 4; ++m) { const size_t row = (size_t)(row0 + ai * HALF + m * 16);
#pragma unroll
                for (int bj = 0; bj < 2; ++bj) { const int c = col0 + bj * HALF; const u32x4 g = gg[ai][m][bj];
                    const f32x4 s0 = acc[ai][bj][m][0] * YSC, s1 = acc[ai][bj][m][1] * YSC;
                    *(u32x2*)(Y + row * YB + 2048 + c) = (u32x2){pk4f8(s0[0] * bflo(g.x), s0[1] * bfhi(g.x), s0[2] * bflo(g.y), s0[3] * bfhi(g.y)), pk4f8(s1[0] * bflo(g.z), s1[1] * bfhi(g.z), s1[2] * bflo(g.w), s1[3] * bfhi(g.w))}; } }
    }
};

template <class Epi, bool ALIGN_EPI, int KIND = 0>
__device__ __forceinline__ void gemm_phase(LAS unsigned char* lds, const Gemm g, const Sched& S, const Epi& E, int wave_s, bool noepi = false) {
    int tid_ = wave_s * 64 + lane_id_v(); asm volatile("" : "+v"(tid_));
    const int tid = tid_, wid = __builtin_amdgcn_readfirstlane(tid >> 6), lane = tid & 63, wr = wid >> 2, wc = wid & 3, fr = lane & 15, fq = lane >> 4;
    const int K = g.K;
    unsigned voffA[2], voffB[2];
#pragma unroll
    for (int i = 0; i < 2; ++i) { int R, C; stage_rc(tid * 16 + i * 8192, R, C); const int Rb = Epi::PERM ? ((R & ~31) + perm32(R & 31)) : R;
        voffA[i] = (unsigned)(R * g.lda + C) * 2u; voffB[i] = (unsigned)(Rb * g.ldb + C) * 2u; }
    const size_t kstep = (size_t)(BK * 2);
    const size_t hsA = (size_t)HALF * g.lda * 2, hsB = (size_t)HALF * g.ldb * 2;
    const size_t tsA = 2 * hsA, tsB = 2 * hsB;
    const unsigned ldsw = (unsigned)wid * 1024u;
    const int aoff = lds_byte(wr * 64 + fr, fq * 8), boff = lds_byte(wc * 32 + fr, fq * 8);
#define PG8_SA(b, h) (((b) * 2 + (h)) * HTB)
#define PG8_SB(b, h) ((4 + (b) * 2 + (h)) * HTB)
#define PG8_STAGE(bufoff, gbase, voff) do { _Pragma("unroll") for (int _i = 0; _i < 2; ++_i) \
        __builtin_amdgcn_global_load_lds((const unsigned*)((const char*)(gbase) + (voff)[_i]), (LAS unsigned*)(lds + (bufoff) + ldsw + _i * 8192), 16, 0, 0); } while (0)
#define PG8_LDA(dst, b, h) do { _Pragma("unroll") for (int m = 0; m < 4; ++m) _Pragma("unroll") for (int k = 0; k < 2; ++k) dst[m][k] = *(const LAS bf16x8*)(lds + PG8_SA(b, h) + aoff + m * 2048 + k * 1024); } while (0)
#define PG8_LDB(dst, b, h) do { _Pragma("unroll") for (int n = 0; n < 2; ++n) _Pragma("unroll") for (int k = 0; k < 2; ++k) dst[n][k] = *(const LAS bf16x8*)(lds + PG8_SB(b, h) + boff + n * 2048 + k * 1024); } while (0)
#define PG8_MMA(TY, ai, bj, At, Bt) do { __builtin_amdgcn_s_setprio(1); _Pragma("unroll") for (int m = 0; m < 4; ++m) _Pragma("unroll") for (int n = 0; n < 2; ++n) { \
        if constexpr ((TY) == 2) { const i32x8 b8_ = __builtin_shufflevector(__builtin_bit_cast(i32x4, Bt[n][0]), __builtin_bit_cast(i32x4, Bt[n][1]), 0, 1, 2, 3, 4, 5, 6, 7), a8_ = __builtin_shufflevector(__builtin_bit_cast(i32x4, At[m][0]), __builtin_bit_cast(i32x4, At[m][1]), 0, 1, 2, 3, 4, 5, 6, 7); \
            asm volatile("v_mfma_f32_16x16x128_f8f6f4 %0, %1, %2, %0" : "+v"(acc[ai][bj][m][n]) : "v"(b8_), "v"(a8_)); }   \
        else { _Pragma("unroll") for (int k = 0; k < 2; ++k) { \
            if constexpr ((TY) == 1) acc[ai][bj][m][n] = __builtin_bit_cast(f32x4, __builtin_amdgcn_mfma_i32_16x16x64_i8(__builtin_bit_cast(i32x4, Bt[n][k]), __builtin_bit_cast(i32x4, At[m][k]), __builtin_bit_cast(i32x4, acc[ai][bj][m][n]), 0, 0, 0)); \
            else acc[ai][bj][m][n] = __builtin_amdgcn_mfma_f32_16x16x32_bf16(Bt[n][k], At[m][k], acc[ai][bj][m][n], 0, 0, 0); } } } __builtin_amdgcn_s_setprio(0); } while (0)
#define PG8_WAIT_V(n) asm volatile("s_waitcnt vmcnt(" #n ")" ::: "memory")
#define PG8_WAIT_L(n) asm volatile("s_waitcnt lgkmcnt(" #n ")" ::: "memory")
#define PG8_BAR __builtin_amdgcn_s_barrier()
#define PG8_SCHED __builtin_amdgcn_sched_barrier(0)
#define PG8_WAIT_VR(nr) do { if (rlx) asm volatile("s_waitcnt vmcnt(" #nr ")" ::: "memory"); else asm volatile("s_waitcnt vmcnt(8)" ::: "memory"); } while (0)
#define PG8_KLOOP(TY) _Pragma("unroll 1") for (int t = 0; t < nt; t += 2) { \
            const bool last = (t == nt - 2), rlx = (t == 0) && (ui > 0); \
            const char* a1 = cA + (size_t)(t + 1) * kstep; \
            const char* a2 = last ? nA : cA + (size_t)(t + 2) * kstep; const char* b2 = last ? nB : cB + (size_t)(t + 2) * kstep; \
            const char* a3 = a2 + kstep; const char* b3 = b2 + kstep; \
            PG8_LDB(B0, 0, 0); PG8_LDB(B1, 0, 1); PG8_SCHED; PG8_LDA(At, 0, 0); PG8_STAGE(PG8_SA(1, 1), a1 + hsA, voffA); \
            PG8_WAIT_VR(26); PG8_WAIT_L(0); PG8_BAR; PG8_MMA(TY, 0, 0, At, B0); PG8_MMA(TY, 0, 1, At, B1); PG8_BAR; PG8_SCHED; \
            PG8_LDA(At, 0, 1); PG8_STAGE(PG8_SB(0, 0), b2, voffB); PG8_STAGE(PG8_SB(0, 1), b2 + hsB, voffB); PG8_STAGE(PG8_SA(0, 0), a2, voffA); \
            PG8_WAIT_VR(30); PG8_WAIT_L(0); PG8_BAR; PG8_MMA(TY, 1, 0, At, B0); PG8_MMA(TY, 1, 1, At, B1); PG8_BAR; PG8_SCHED; \
            PG8_LDB(B0, 1, 0); PG8_LDB(B1, 1, 1); PG8_SCHED; PG8_LDA(At, 1, 0); PG8_STAGE(PG8_SA(0, 1), a2 + hsA, voffA); \
            PG8_WAIT_VR(26); PG8_WAIT_L(0); PG8_BAR; PG8_MMA(TY, 0, 0, At, B0); PG8_MMA(TY, 0, 1, At, B1); PG8_BAR; PG8_SCHED; \
            PG8_LDA(At, 1, 1); PG8_STAGE(PG8_SB(1, 0), b3, voffB); PG8_STAGE(PG8_SB(1, 1), b3 + hsB, voffB); PG8_STAGE(PG8_SA(1, 0), a3, voffA); \
            PG8_WAIT_VR(14); PG8_WAIT_L(0); PG8_BAR; PG8_MMA(TY, 1, 0, At, B0); PG8_MMA(TY, 1, 1, At, B1); PG8_BAR; PG8_SCHED; \
        }
    Unit cur, nxt; int ui = 0;
    if (!S.next(0, cur)) return;
    f32x4 acc[2][2][4][2];
#pragma unroll
    for (int a = 0; a < 2; ++a)
#pragma unroll
        for (int b = 0; b < 2; ++b)
#pragma unroll
            for (int m = 0; m < 4; ++m)
#pragma unroll
                for (int n = 0; n < 2; ++n) acc[a][b][m][n] = (f32x4){0.f, 0.f, 0.f, 0.f};
    bf16x8 At[4][2], B0[2][2], B1[2][2];
    const char* cA = (const char*)g.A + (size_t)cur.pm * tsA + (size_t)cur.z * g.azs; const char* cB = (const char*)g.Bt + (size_t)cur.pn * tsB + (size_t)cur.z * g.bzs + (size_t)(cur.pm >> 4) * g.bbs;
    PG8_STAGE(PG8_SB(0, 0), cB, voffB); PG8_STAGE(PG8_SB(0, 1), cB + hsB, voffB); PG8_STAGE(PG8_SA(0, 0), cA, voffA); PG8_STAGE(PG8_SA(0, 1), cA + hsA, voffA);
    if (wr == 1) PG8_BAR;
    PG8_WAIT_V(2); PG8_BAR;
    PG8_STAGE(PG8_SB(1, 0), cB + kstep, voffB); PG8_STAGE(PG8_SA(1, 0), cA + kstep, voffA); PG8_STAGE(PG8_SB(1, 1), cB + hsB + kstep, voffB);
    PG8_WAIT_V(6); PG8_BAR;
    for (;;) {
        cur.par = ui & 1;
        if constexpr (KIND == 1) E.prefetch(cur, wid, lane_id_v());
        const bool has_next = S.next(ui + 1, nxt);
        const char* nA = has_next ? (const char*)g.A + (size_t)nxt.pm * tsA + (size_t)nxt.z * g.azs : cA;
        const char* nB = has_next ? (const char*)g.Bt + (size_t)nxt.pn * tsB + (size_t)nxt.z * g.bzs + (size_t)(nxt.pm >> 4) * g.bbs : cB;
        const int nt = K / BK;
        PG8_KLOOP(KIND)
        if constexpr (KIND == 2) asm volatile("s_nop 15\n\ts_nop 7" ::: "memory");
        if constexpr (ALIGN_EPI) { if (wr == 0) PG8_BAR; }
        if (!noepi) { const int l2 = lane_id_v(); E(acc, cur, wr, wc, l2 & 15, l2 >> 4); }
        if (!has_next) break;
        if (!Epi::keep(cur)) {
#pragma unroll
        for (int a = 0; a < 2; ++a)
#pragma unroll
            for (int b = 0; b < 2; ++b)
#pragma unroll
                for (int m = 0; m < 4; ++m)
#pragma unroll
                    for (int n = 0; n < 2; ++n) acc[a][b][m][n] = (f32x4){0.f, 0.f, 0.f, 0.f};
        }
        cur = nxt; cA = nA; cB = nB; ++ui;
        if constexpr (ALIGN_EPI) { if (wr == 1) PG8_BAR; }
    }
    PG8_WAIT_V(0);
    if constexpr (!ALIGN_EPI) { if (wr == 0) PG8_BAR; }
    PG8_BAR;
#undef PG8_SA
#undef PG8_SB
#undef PG8_STAGE
#undef PG8_LDA
#undef PG8_LDB
#undef PG8_MMA
#undef PG8_KLOOP
#undef PG8_WAIT_VR
#undef PG8_WAIT_V
#undef PG8_WAIT_L
#undef PG8_BAR
#undef PG8_SCHED
}
}


namespace att {
using s16x4  = __attribute__((ext_vector_type(4))) short;
using f32x16 = __attribute__((ext_vector_type(16))) float;
constexpr int D = 128, NW = 8, QBLK = 32, KVBLK = 64;
constexpr float SCALE = 0.088388347648318440f, THR = 8.f;
constexpr int SHM_V = KVBLK * D * 2, SHM_K = KVBLK * D * 2, SHM_ATTN = 2 * SHM_V + 2 * SHM_K + NW * 64 * 4, KM_OFF = SHM_ATTN, KM_BYTES = 16 * 128 * 4, ATT_LDS = KM_OFF + KM_BYTES;
#define KSWZ(row, colB) ((row) * 256 + ((colB) ^ (((row) & 7) << 4)))
#define SBAR() __builtin_amdgcn_sched_barrier(0)
__device__ __forceinline__ int crow(int r, int hi) { return (r & 3) + 8 * (r >> 2) + 4 * hi; }
__device__ __forceinline__ unsigned cvtpk(float lo, float hi) { unsigned r; asm volatile("v_cvt_pk_bf16_f32 %0, %1, %2" : "=v"(r) : "v"(lo), "v"(hi)); return r; }

struct MaskInfo { unsigned sel; int qrel; int qb; u32x2 w; };
template <int MODE>
__device__ __forceinline__ void apply_mask(f32x16& p0, f32x16& p1, const MaskInfo& mi, int j, int hi) {
    const float NEG = -INFINITY;
    if (MODE == 0) {
        const int blk = j >> 2;
        if (blk == mi.qb) { const int kb = 64 * (j & 3) + 4 * hi;
#pragma unroll
            for (int r = 0; r < 16; ++r) { const int kv = kb + (r & 3) + 8 * (r >> 2); if (kv > mi.qrel) p0[r] = NEG; if (kv + 32 > mi.qrel) p1[r] = NEG; } }
    } else {
        const unsigned w0 = mi.w.x >> (4 * hi), w1 = mi.w.y >> (4 * hi);
#pragma unroll
        for (int r = 0; r < 16; ++r) { const unsigned bit = 1u << ((r & 3) + 8 * (r >> 2)); p0[r] = (w0 & bit) ? p0[r] : NEG; p1[r] = (w1 & bit) ? p1[r] : NEG; }
    }
}
__device__ __forceinline__ void partialSM(f32x16& p0, f32x16& p1, float& m_reg, float& mn, float& alpha, bool rowon) {
    constexpr float C = SCALE * 1.4426950408889634f;
    float pmax = p0[0];
#pragma unroll
    for (int r = 1; r < 16; ++r) pmax = fmaxf(pmax, p0[r]);
#pragma unroll
    for (int r = 0; r < 16; ++r) pmax = fmaxf(pmax, p1[r]);
    { auto rr = __builtin_amdgcn_permlane32_swap(__float_as_uint(pmax), __float_as_uint(pmax), false, false);
      pmax = fmaxf(__uint_as_float(rr[0]), __uint_as_float(rr[1])); }
    pmax = rowon ? pmax : -INFINITY;
    if (__builtin_expect(__all(pmax - m_reg <= THR / SCALE), 1)) { mn = m_reg; alpha = 1.f; }
    else { mn = fmaxf(m_reg, pmax); alpha = __builtin_amdgcn_exp2f((m_reg - mn) * C); m_reg = mn; }
    const float mnC = rowon ? -mn * C : -INFINITY;
#pragma unroll
    for (int r = 0; r < 16; ++r) p0[r] = fmaf(p0[r], C, mnC);
#pragma unroll
    for (int r = 0; r < 16; ++r) p1[r] = fmaf(p1[r], C, mnC);
#pragma unroll
    for (int r = 0; r < 16; ++r) p0[r] = __builtin_amdgcn_exp2f(p0[r]);
}
__device__ __forceinline__ void finishSM(f32x16& p0, f32x16& p1, float alpha, float& l_reg, bf16x8& pa0, bf16x8& pa1, bf16x8& pa2, bf16x8& pa3) {
#pragma unroll
    for (int r = 0; r < 16; ++r) p1[r] = __builtin_amdgcn_exp2f(p1[r]);
    float ps = 0;
#pragma unroll
    for (int r = 0; r < 16; ++r) ps += p0[r];
#pragma unroll
    for (int r = 0; r < 16; ++r) ps += p1[r];
    { auto rr = __builtin_amdgcn_permlane32_swap(__float_as_uint(ps), __float_as_uint(ps), false, false);
      ps = __uint_as_float(rr[0]) + __uint_as_float(rr[1]); }
    l_reg = l_reg * alpha + ps;
#define PK4(P, BASE, OUT) do { unsigned a0 = cvtpk(P[BASE + 0], P[BASE + 1]), a1 = cvtpk(P[BASE + 2], P[BASE + 3]);   \
    unsigned b0 = cvtpk(P[BASE + 4], P[BASE + 5]), b1 = cvtpk(P[BASE + 6], P[BASE + 7]);                              \
    auto r0 = __builtin_amdgcn_permlane32_swap(a0, b0, false, false); auto r1 = __builtin_amdgcn_permlane32_swap(a1, b1, false, false); \
    u32x4 w = {r0[0], r1[0], r0[1], r1[1]}; OUT = *reinterpret_cast<bf16x8*>(&w); } while (0)
    PK4(p0, 0, pa0); PK4(p0, 8, pa1); PK4(p1, 0, pa2); PK4(p1, 8, pa3);
#undef PK4
}
__device__ __forceinline__ void qkt(f32x16& p0, f32x16& p1, const LAS char* Ks, const bf16x8* qr, int r32, int hi) {
    p0 = f32x16{}; p1 = f32x16{};
#pragma unroll
    for (int d0 = 0; d0 < 8; ++d0) { const int cb = (d0 * 16 + hi * 8) * 2;
        const bf16x8 b0 = *reinterpret_cast<const LAS bf16x8*>(Ks + KSWZ(r32, cb));
        const bf16x8 b1 = *reinterpret_cast<const LAS bf16x8*>(Ks + KSWZ(32 + r32, cb));
        p0 = __builtin_amdgcn_mfma_f32_32x32x16_bf16(b0, qr[d0], p0, 0, 0, 0);
        p1 = __builtin_amdgcn_mfma_f32_32x32x16_bf16(b1, qr[d0], p1, 0, 0, 0); }
}
__device__ __forceinline__ int v_st(int k, int c) { const int kk = (k & ~0xC) | ((k & 4) << 1) | ((k & 8) >> 1); return ((kk >> 3) * 4 + (c >> 5)) * 512 + ((kk & 7) * 32 + (c & 31)) * 2; }
__device__ __forceinline__ int v_rd_base(int lane) { return ((lane & 3) << 3) | (((lane >> 2) & 3) << 6) | (((lane >> 4) & 1) << 5) | (((lane >> 5) & 1) << 8); }
constexpr int v_rd_off(int d0, int ks, int half) { return d0 * 512 + ks * 4096 + half * 2048; }
template <int OFF> __device__ __forceinline__ s16x4 tr_read(int vb) {
    s16x4 r; asm volatile("ds_read_b64_tr_b16 %0, %1 offset:%2" : "=&v"(r) : "v"(vb), "i"(OFF) : "memory"); return r;
}
template <int D0> __device__ __forceinline__ void pv_one(f32x16& od, int vb, bf16x8 pa0, bf16x8 pa1, bf16x8 pa2, bf16x8 pa3) {
    const s16x4 l0 = tr_read<v_rd_off(D0, 0, 0)>(vb), h0 = tr_read<v_rd_off(D0, 0, 1)>(vb), l1 = tr_read<v_rd_off(D0, 1, 0)>(vb), h1 = tr_read<v_rd_off(D0, 1, 1)>(vb);
    const s16x4 l2 = tr_read<v_rd_off(D0, 2, 0)>(vb), h2 = tr_read<v_rd_off(D0, 2, 1)>(vb), l3 = tr_read<v_rd_off(D0, 3, 0)>(vb), h3 = tr_read<v_rd_off(D0, 3, 1)>(vb);
    asm volatile("s_waitcnt lgkmcnt(0)" ::: "memory"); SBAR();
#define PK(L, H) (bf16x8){L[0], L[1], L[2], L[3], H[0], H[1], H[2], H[3]}
    od = __builtin_amdgcn_mfma_f32_32x32x16_bf16(pa0, PK(l0, h0), od, 0, 0, 0);
    od = __builtin_amdgcn_mfma_f32_32x32x16_bf16(pa1, PK(l1, h1), od, 0, 0, 0);
    od = __builtin_amdgcn_mfma_f32_32x32x16_bf16(pa2, PK(l2, h2), od, 0, 0, 0);
    od = __builtin_amdgcn_mfma_f32_32x32x16_bf16(pa3, PK(l3, h3), od, 0, 0, 0);
#undef PK
}
__device__ __forceinline__ void pv_d0(f32x16* o, int vb, bf16x8 pa0, bf16x8 pa1, bf16x8 pa2, bf16x8 pa3) {
    pv_one<0>(o[0], vb, pa0, pa1, pa2, pa3); pv_one<1>(o[1], vb, pa0, pa1, pa2, pa3); pv_one<2>(o[2], vb, pa0, pa1, pa2, pa3); pv_one<3>(o[3], vb, pa0, pa1, pa2, pa3);
}

template <int MODE>
__device__ __forceinline__ void attn_unit(const bf16_t* __restrict__ Qb, const bf16_t* __restrict__ Kh, const bf16_t* __restrict__ Vh, const bf16_t* __restrict__ Gb, unsigned char* __restrict__ Yb,
                                          const float* __restrict__ km, const unsigned* __restrict__ mrow0, int qb, LAS char* lds, int wave_s) {
    int tid_ = wave_s * 64 + lane_id_v(); asm volatile("" : "+v"(tid_));
    const int tid = tid_, wid = tid >> 6, lane = tid & 63, r32 = lane & 31, hi = lane >> 5;
    constexpr long LDQ = NPO, LDK = NPO;
    LAS char* V_lds = lds; LAS char* K_lds = lds + 2 * SHM_V;
    LAS float* wsl = (LAS float*)(lds + 2 * SHM_V + 2 * SHM_K) + wid * 64; LAS float* li_l = wsl; LAS float* al_l = wsl + 32;
    float m_reg = -1e30f, l_reg = 0; f32x16 o[4] = {}; bf16x8 qr[8];
    const bf16_t* Qw = Qb + (long)(wid * QBLK + r32) * LDQ + hi * 8;
#pragma unroll
    for (int d0 = 0; d0 < 8; ++d0) qr[d0] = *reinterpret_cast<const bf16x8*>(Qw + d0 * 16);
    MaskInfo mi; mi.sel = 0u; mi.qrel = wid * QBLK + r32; mi.qb = qb; mi.w = (u32x2){0u, 0u};
    const unsigned* mrow = nullptr;
    if (MODE == 0) {
        LAS float* kms = (LAS float*)(lds + KM_OFF);
        *(LAS f32x4*)(kms + tid * 4) = *(const f32x4*)(km + tid * 4);
        __syncthreads();
        if (qb <= 3) mi.sel = (1u << qb) - 1u;
        else {
            float qf[64];
#pragma unroll
            for (int d0 = 0; d0 < 8; ++d0)
#pragma unroll
                for (int e = 0; e < 8; ++e) qf[d0 * 8 + e] = bf2f((unsigned short)qr[d0][e]);
            float bs[15];
#pragma unroll
            for (int n = 0; n < 15; ++n) { float s = 0.f;
                if (n < qb) {
#pragma unroll
                    for (int d0 = 0; d0 < 8; ++d0) { const f32x4 k0 = *(const LAS f32x4*)(kms + n * 128 + d0 * 16 + hi * 8), k1 = *(const LAS f32x4*)(kms + n * 128 + d0 * 16 + hi * 8 + 4);
                        s += qf[d0 * 8 + 0] * k0.x + qf[d0 * 8 + 1] * k0.y + qf[d0 * 8 + 2] * k0.z + qf[d0 * 8 + 3] * k0.w + qf[d0 * 8 + 4] * k1.x + qf[d0 * 8 + 5] * k1.y + qf[d0 * 8 + 6] * k1.z + qf[d0 * 8 + 7] * k1.w; }
                    s += __shfl_xor(s, 32); }
                bs[n] = s; }
            unsigned chosen = 0u;
#pragma unroll
            for (int rr = 0; rr < 3; ++rr) { float best = 0.f; int bi = -1;
#pragma unroll
                for (int n = 0; n < 15; ++n) { const bool ok = (n < qb) && !((chosen >> n) & 1u) && (bi < 0 || bs[n] > best); best = ok ? bs[n] : best; bi = ok ? n : bi; }
                chosen |= 1u << bi; }
            mi.sel = chosen;
        }
    } else {
        mrow = mrow0 + (size_t)(wid * QBLK + r32) * 128;
    }
    const int sr = tid >> 4, sc = (tid & 15) * 8, vst0 = v_st(sr, sc), vst1 = v_st(32 + sr, sc);
    const int vb0 = (int)(unsigned)(uintptr_t)V_lds + v_rd_base(lane);
    struct { bf16x8 vs0, vs1, ks0, ks1; } sr_[2];
#define SLOAD(i, k0) do { sr_[i].vs0 = *reinterpret_cast<const bf16x8*>(&Vh[(long)((k0) + sr) * LDK + sc]); sr_[i].vs1 = *reinterpret_cast<const bf16x8*>(&Vh[(long)((k0) + 32 + sr) * LDK + sc]); \
    sr_[i].ks0 = *reinterpret_cast<const bf16x8*>(&Kh[(long)((k0) + sr) * LDK + sc]); sr_[i].ks1 = *reinterpret_cast<const bf16x8*>(&Kh[(long)((k0) + 32 + sr) * LDK + sc]); } while (0)
#define SWRITE(b, i) do { *(LAS bf16x8*)(V_lds + (b) * SHM_V + vst0) = sr_[i].vs0;          \
    *(LAS bf16x8*)(V_lds + (b) * SHM_V + vst1) = sr_[i].vs1; const int kc = sc * 2;               \
    *(LAS bf16x8*)(K_lds + (b) * SHM_K + KSWZ(sr, kc)) = sr_[i].ks0;                       \
    *(LAS bf16x8*)(K_lds + (b) * SHM_K + KSWZ(32 + sr, kc)) = sr_[i].ks1; } while (0)
#define SWAIT() asm volatile("s_waitcnt vmcnt(4)" ::: "memory")
#define RESC(a) do { if (__any((a) < 1.f)) { if (hi == 0) al_l[r32] = (a); asm volatile("s_waitcnt lgkmcnt(0)" ::: "memory"); \
    _Pragma("unroll") for (int d = 0; d < 4; ++d) _Pragma("unroll") for (int r = 0; r < 16; ++r) o[d][r] *= al_l[crow(r, hi)]; } } while (0)
#define MLOAD(dst, j) do { if (MODE == 1) dst = *(const u32x2*)(mrow + 2 * (j)); } while (0)
#define ROWON(j) (MODE == 1 || ((j) >> 2) == qb || ((mi.sel >> ((j) >> 2)) & 1u))
    f32x16 pA0, pA1, pB0, pB1; float mnA, mnB, alA, alB; bf16x8 pa0, pa1, pa2, pa3; const int NT = 4 * (qb + 1);
    u32x2 mA = (u32x2){0u, 0u}, mB = (u32x2){0u, 0u};
    constexpr int SE = 0, SO = 1;
    MLOAD(mA, 0); MLOAD(mB, 1);
    SLOAD(SE, 0); asm volatile("s_waitcnt vmcnt(0)" ::: "memory"); SWRITE(0, SE); __syncthreads();
    qkt(pA0, pA1, K_lds, qr, r32, hi); mi.w = mA; apply_mask<MODE>(pA0, pA1, mi, 0, hi); partialSM(pA0, pA1, m_reg, mnA, alA, ROWON(0)); MLOAD(mA, 2);
    SLOAD(SO, KVBLK); if (2 < NT) SLOAD(SE, 2 * KVBLK);
    SWAIT(); SWRITE(1, SO); __syncthreads();
    for (int j = 1; j + 1 < NT; j += 2) {
        SBAR(); qkt(pB0, pB1, K_lds + SHM_K, qr, r32, hi);
        finishSM(pA0, pA1, alA, l_reg, pa0, pa1, pa2, pa3); SBAR();
        SLOAD(SO, (j + 2) * KVBLK); SBAR();
        pv_d0(o, vb0, pa0, pa1, pa2, pa3); mi.w = mB; apply_mask<MODE>(pB0, pB1, mi, j, hi); partialSM(pB0, pB1, m_reg, mnB, alB, ROWON(j)); MLOAD(mB, j + 2);
        __syncthreads(); SWAIT(); SWRITE(0, SE);
        RESC(alB); __syncthreads();
        SBAR(); qkt(pA0, pA1, K_lds, qr, r32, hi);
        finishSM(pB0, pB1, alB, l_reg, pa0, pa1, pa2, pa3); SBAR();
        if (j + 3 < NT) SLOAD(SE, (j + 3) * KVBLK); SBAR();
        pv_d0(o, vb0 + SHM_V, pa0, pa1, pa2, pa3); mi.w = mA; apply_mask<MODE>(pA0, pA1, mi, j + 1, hi); partialSM(pA0, pA1, m_reg, mnA, alA, ROWON(j + 1)); if (j + 3 < NT) MLOAD(mA, j + 3);
        __syncthreads(); SWAIT(); SWRITE(1, SO);
        RESC(alA); __syncthreads();
    }
    SBAR(); qkt(pB0, pB1, K_lds + SHM_K, qr, r32, hi);
    finishSM(pA0, pA1, alA, l_reg, pa0, pa1, pa2, pa3); SBAR();
    pv_d0(o, vb0, pa0, pa1, pa2, pa3); mi.w = mB; apply_mask<MODE>(pB0, pB1, mi, NT - 1, hi); partialSM(pB0, pB1, m_reg, mnB, alB, ROWON(NT - 1));
    __syncthreads(); RESC(alB);
    finishSM(pB0, pB1, alB, l_reg, pa0, pa1, pa2, pa3); SBAR();
    pv_d0(o, vb0 + SHM_V, pa0, pa1, pa2, pa3);
    if (hi == 0) li_l[r32] = l_reg; asm volatile("s_waitcnt lgkmcnt(0)" ::: "memory");
    float rli[16];
#pragma unroll
    for (int r = 0; r < 16; ++r) rli[r] = __builtin_amdgcn_rcpf(li_l[crow(r, hi)]);
    __syncthreads();
    LAS float* ost = (LAS float*)(lds + wid * 16384);
#pragma unroll
    for (int r = 0; r < 16; ++r) { const int orow = crow(r, hi);
#pragma unroll
        for (int d0 = 0; d0 < 4; ++d0) ost[orow * 128 + d0 * 32 + r32] = o[d0][r] * rli[r]; }
    asm volatile("s_waitcnt lgkmcnt(0)" ::: "memory");
    const bf16_t* Gw = Gb + (long)(wid * QBLK) * LDQ; unsigned char* Yw = Yb + (long)(wid * QBLK) * YB;
    u32x4 gg[8];
#pragma unroll
    for (int i = 0; i < 8; ++i) { const int k = lane + 64 * i, row = k >> 4, cc = (k & 15) * 8; gg[i] = *(const u32x4*)(Gw + (long)row * LDQ + cc); }
#pragma unroll
    for (int i = 0; i < 8; ++i) { const int k = lane + 64 * i, row = k >> 4, cc = (k & 15) * 8;
        const f32x4 a0 = *(const LAS f32x4*)(ost + row * 128 + cc), a1 = *(const LAS f32x4*)(ost + row * 128 + cc + 4);
        const u32x4 g = gg[i];
        const f32x4 s0 = a0 * YSC, s1 = a1 * YSC;
        *(u32x2*)(Yw + (long)row * YB + cc) = (u32x2){pk4f8(s0[0] * bflo(g.x), s0[1] * bfhi(g.x), s0[2] * bflo(g.y), s0[3] * bfhi(g.y)), pk4f8(s1[0] * bflo(g.z), s1[1] * bfhi(g.z), s1[2] * bflo(g.w), s1[3] * bfhi(g.w))}; }
    __syncthreads();
#undef SLOAD
#undef SWRITE
#undef SWAIT
#undef RESC
#undef MLOAD
#undef ROWON
}
#undef KSWZ
#undef SBAR
}

namespace tk {
using f32x16 = __attribute__((ext_vector_type(16))) float;
constexpr int CAP = 64;
constexpr int H_OFF = 0, SEL_OFF = 32768 + 256  , EQ_OFF = SEL_OFF + 16640, ST_OFF = EQ_OFF + 16640, PS_OFF = ST_OFF + 512, TK_LDS = PS_OFF + 2048, PITCH = 129;
__device__ __forceinline__ void topk_unit(const bf16_t* __restrict__ IQC, const bf16_t* __restrict__ IKC, const float* __restrict__ IDX, unsigned* __restrict__ maskw, unsigned* __restrict__ scr, int b, int ui, LAS char* lds, int wave_s, int mode = 0) {
    int tid_ = wave_s * 64 + lane_id_v(); asm volatile("" : "+v"(tid_));
    const int tid = tid_, wid = tid >> 6, lane = tid & 63, r32 = lane & 31, hi = lane >> 5;
    LAS unsigned* hist = (LAS unsigned*)(lds + H_OFF); LAS unsigned* selb = (LAS unsigned*)(lds + SEL_OFF); LAS unsigned* eqb = (LAS unsigned*)(lds + EQ_OFF);
    LAS unsigned* st = (LAS unsigned*)(lds + ST_OFF); LAS unsigned* psum = (LAS unsigned*)(lds + PS_OFF);
    const int pos0 = ui * 32; const size_t tokq = (size_t)b * SEQ + pos0 + r32;
    bf16x8 bq[4][4];
#pragma unroll
    for (int j = 0; j < 4; ++j)
#pragma unroll
        for (int kk = 0; kk < 4; ++kk) bq[j][kk] = *reinterpret_cast<const bf16x8*>(IQC + tokq * 256 + j * 64 + kk * 16 + hi * 8);
    float wj[4];
#pragma unroll
    for (int j = 0; j < 4; ++j) wj[j] = IDX[tokq * 4 + j] * 0.0625f;
    for (int i = tid; i < 8192; i += 512) hist[i] = 0u;
    for (int i = tid; i < 32 * PITCH; i += 512) selb[i] = 0u;
    if (tid < 32) { st[tid] = 0u; const int n = pos0 + tid + 1; st[32 + tid] = (unsigned)(n < 256 ? n : 256); st[64 + tid] = 0u; if (tid == 0) st[96] = (mode == 1) ? 1u : 0u; }
    __syncthreads();
    const int ntile = ui + 1;
    const bf16_t* kbase = IKC + ((size_t)b * SEQ + r32) * 64 + hi * 8;
    u32x4* scr4 = (u32x4*)scr + lane;
#ifndef PROBE_TK
#define PROBE_TK 0
#endif
    for (int rp0 = 0; rp0 < (PROBE_TK == 1 ? 2 : 1); ++rp0) {
        if (rp0) { __syncthreads(); for (int i = tid; i < 8192; i += 512) hist[i] = 0u; __syncthreads(); }
        bf16x8 an[4], an2[4];
        if (wid < ntile) {
#pragma unroll
            for (int kk = 0; kk < 4; ++kk) an[kk] = *reinterpret_cast<const bf16x8*>(kbase + (size_t)(wid * 32) * 64 + kk * 16);
        }
        if (wid + 8 < ntile) {
#pragma unroll
            for (int kk = 0; kk < 4; ++kk) an2[kk] = *reinterpret_cast<const bf16x8*>(kbase + (size_t)((wid + 8) * 32) * 64 + kk * 16);
        }
        for (int tile = wid; tile < ntile; tile += 8) {
            bf16x8 a[4];
#pragma unroll
            for (int kk = 0; kk < 4; ++kk) { a[kk] = an[kk]; an[kk] = an2[kk]; }
            if (tile + 16 < ntile) {
#pragma unroll
                for (int kk = 0; kk < 4; ++kk) an2[kk] = *reinterpret_cast<const bf16x8*>(kbase + (size_t)((tile + 16) * 32) * 64 + kk * 16);
            }
            f32x16 acc[4];
#pragma unroll
            for (int j = 0; j < 4; ++j) { acc[j] = f32x16{};
#pragma unroll
                for (int kk = 0; kk < 4; ++kk) acc[j] = __builtin_amdgcn_mfma_f32_32x32x16_bf16(a[kk], bq[j][kk], acc[j], 0, 0, 0); }
            const bool diag = (tile == ui);
            unsigned keys[16];
#pragma unroll
            for (int r = 0; r < 16; ++r) {
                float sc = wj[0] * relu_i(acc[0][r]); sc = fmaf(wj[1], relu_i(acc[1][r]), sc); sc = fmaf(wj[2], relu_i(acc[2][r]), sc); sc = fmaf(wj[3], relu_i(acc[3][r]), sc);
                unsigned u = __float_as_uint(sc); u = (u == 0x80000000u) ? 0u : u;
                const unsigned key = (u & 0x80000000u) ? ~u : (u | 0x80000000u);
                keys[r] = key;
                const int kk_ = (r & 3) + 8 * (r >> 2) + 4 * hi;
                const bool valid = !diag || kk_ <= r32;
                atomicAdd((unsigned*)&hist[(valid ? (key >> 24) : 256u) * 32 + r32], 1u);
            }
#pragma unroll
            for (int j = 0; j < 4; ++j) scr4[(size_t)(tile * 4 + j) * 64] = (u32x4){keys[4 * j], keys[4 * j + 1], keys[4 * j + 2], keys[4 * j + 3]};
        }
    }
    __syncthreads();
    bool short_done = false;
    for (int pass = 0; pass < 5; ++pass) {
        if (pass == 2 && st[96] == 0u) {
            LAS unsigned* clist = hist; LAS unsigned* ccnt = psum;
            if (tid < 32) ccnt[tid] = 0u;
            const unsigned pfx16 = st[r32];
            for (int base = wid; base < ntile; base += 32) {
                u32x4 kb[4][4];
#pragma unroll
                for (int t8 = 0; t8 < 4; ++t8) { const int tile = base + 8 * t8;
                    if (tile < ntile) {
#pragma unroll
                        for (int j = 0; j < 4; ++j) kb[t8][j] = scr4[(size_t)(tile * 4 + j) * 64]; } }
#pragma unroll
                for (int t8 = 0; t8 < 4; ++t8) { const int tile = base + 8 * t8;
                    if (tile < ntile) {
                        const bool diag = (tile == ui);
                        unsigned gtw = 0u, eqw = 0u;
#pragma unroll
                        for (int r = 0; r < 16; ++r) {
                            const unsigned key = kb[t8][r >> 2][r & 3];
                            const int kk_ = (r & 3) + 8 * (r >> 2) + 4 * hi;
                            const bool valid = !diag || kk_ <= r32;
                            gtw |= (valid && (key >> 16) > pfx16) ? (1u << kk_) : 0u; eqw |= (valid && (key >> 16) == pfx16) ? (1u << kk_) : 0u;
                        }
                        gtw |= __shfl_xor(gtw, 32); eqw |= __shfl_xor(eqw, 32); if (hi == 0) { selb[r32 * PITCH + tile] = gtw; eqb[r32 * PITCH + tile] = eqw; }
                    } }
            }
            __syncthreads();
            { const int q = tid >> 4, c16 = tid & 15;
              for (int tile = c16; tile < ntile; tile += 16) { unsigned ee = eqb[q * PITCH + tile];
                  while (ee) { const int kk_ = __builtin_ctz(ee); ee &= ee - 1u;
                      const int r = (kk_ & 3) + 4 * (kk_ >> 3), ln = q + 32 * ((kk_ >> 2) & 1);
                      const unsigned key = __hip_atomic_load(scr + ((size_t)(tile * 4 + (r >> 2)) * 64 + ln) * 4 + (r & 3), __ATOMIC_RELAXED, __HIP_MEMORY_SCOPE_AGENT);
                      const unsigned slot = atomicAdd((unsigned*)&ccnt[q], 1u);
                      if (slot < (unsigned)CAP) clist[q * CAP + slot] = ((key & 0xffffu) << 16) | (0xffffu - (unsigned)(tile * 32 + kk_)); } } }
            __syncthreads();
            { const int q = tid >> 4; const unsigned cnt = ccnt[q] < (unsigned)CAP ? ccnt[q] : (unsigned)CAP, need = st[32 + q];
              for (unsigned i = (unsigned)(tid & 15); i < cnt; i += 16u) { const unsigned v = clist[q * CAP + i]; unsigned rank = 0u;
                  for (unsigned j = 0; j < cnt; ++j) rank += (clist[q * CAP + j] > v) ? 1u : 0u;
                  if (rank < need) { const unsigned kpos = 0xffffu - (v & 0xffffu); atomicOr((unsigned*)&selb[q * PITCH + (kpos >> 5)], 1u << (kpos & 31u)); } } }
            short_done = true;
            break;
        }
        if (pass > 0) {
            const unsigned prefix = st[r32];
            const int sh = 24 - 8 * (pass < 4 ? pass : 3);
            if (pass < 4) {
                for (int base = wid; base < ntile; base += 32) {
                    u32x4 kb[4][4];
#pragma unroll
                    for (int t8 = 0; t8 < 4; ++t8) { const int tile = base + 8 * t8;
                        if (tile < ntile) {
#pragma unroll
                            for (int j = 0; j < 4; ++j) kb[t8][j] = scr4[(size_t)(tile * 4 + j) * 64]; } }
#pragma unroll
                    for (int t8 = 0; t8 < 4; ++t8) { const int tile = base + 8 * t8;
                        if (tile < ntile) {
                            const bool diag = (tile == ui);
#pragma unroll
                            for (int r = 0; r < 16; ++r) {
                                const unsigned key = kb[t8][r >> 2][r & 3];
                                const int kk_ = (r & 3) + 8 * (r >> 2) + 4 * hi;
                                const bool match = (!diag || kk_ <= r32) && ((key >> (sh + 8)) == prefix);
                                atomicAdd((unsigned*)&hist[(match ? ((key >> sh) & 255u) : 256u) * 32 + r32], 1u);
                            }
                        } }
                }
            } else {
                for (int base = wid; base < ntile; base += 32) {
                    u32x4 kb[4][4];
#pragma unroll
                    for (int t8 = 0; t8 < 4; ++t8) { const int tile = base + 8 * t8;
                        if (tile < ntile) {
#pragma unroll
                            for (int j = 0; j < 4; ++j) kb[t8][j] = scr4[(size_t)(tile * 4 + j) * 64]; } }
#pragma unroll
                    for (int t8 = 0; t8 < 4; ++t8) { const int tile = base + 8 * t8;
                        if (tile < ntile) {
                            const bool diag = (tile == ui);
                            unsigned gtw = 0u, eqw = 0u;
#pragma unroll
                            for (int r = 0; r < 16; ++r) {
                                const unsigned key = kb[t8][r >> 2][r & 3];
                                const int kk_ = (r & 3) + 8 * (r >> 2) + 4 * hi;
                                const bool valid = !diag || kk_ <= r32;
                                gtw |= (valid && key > prefix) ? (1u << kk_) : 0u; eqw |= (valid && key == prefix) ? (1u << kk_) : 0u;
                            }
                            gtw |= __shfl_xor(gtw, 32); eqw |= __shfl_xor(eqw, 32); if (hi == 0) { selb[r32 * PITCH + tile] = gtw | eqw; eqb[r32 * PITCH + tile] = eqw; }
                        } }
                }
            }
            __syncthreads();
        }
        if (pass < 4) {
            const int q = tid & 31, part = tid >> 5;
            unsigned c[16]; unsigned lsum = 0u;
#pragma unroll
            for (int i = 0; i < 16; ++i) { c[i] = hist[(16 * part + i) * 32 + q]; lsum += c[i]; }
            const unsigned needq = st[32 + q], pfx = st[q];
            psum[part * 32 + q] = lsum;
            __syncthreads();
            unsigned above = 0u;
            for (int p2 = part + 1; p2 < 16; ++p2) above += psum[p2 * 32 + q];
            if (above < needq && needq <= above + lsum) {
                bool done = false;
#pragma unroll
                for (int i = 15; i >= 0; --i) { if (!done) { if (above + c[i] >= needq) { st[q] = (pfx << 8) | (unsigned)(16 * part + i); st[32 + q] = needq - above; st[64 + q] = c[i]; if (pass == 1 && c[i] > (unsigned)CAP) st[96] = 1u; done = true; } else above += c[i]; } }
            }
#pragma unroll
            for (int i = 0; i < 16; ++i) hist[(16 * part + i) * 32 + q] = 0u;
            __syncthreads();
        }
    }
    if (!short_done && tid < 32) { const int q = tid; const unsigned need = st[32 + q], cnt = st[64 + q];
        if (cnt > need) { unsigned seen = 0u;
            for (int tile = 0; tile <= ui; ++tile) { const unsigned e = eqb[q * PITCH + tile];
                if (e) { const unsigned k = (unsigned)__builtin_popcount(e);
                    if (seen + k <= need) seen += k;
                    else { const unsigned keep = need - seen; unsigned km = 0u, ee = e; for (unsigned i = 0; i < keep; ++i) { const unsigned low = ee & (0u - ee); km |= low; ee ^= low; }
                        selb[q * PITCH + tile] &= ~(e & ~km); seen = need; } } } } }
    __syncthreads();
    { const int q = tid >> 4, c = tid & 15;
      if (c <= (ui >> 3)) { u32x4 w0, w1; const LAS unsigned* sp = selb + q * PITCH + 8 * c;
          w0.x = sp[0]; w0.y = sp[1]; w0.z = sp[2]; w0.w = sp[3]; w1.x = sp[4]; w1.y = sp[5]; w1.z = sp[6]; w1.w = sp[7];
          unsigned* gp = maskw + ((size_t)b * SEQ + pos0 + q) * 128 + 8 * c; *(u32x4*)gp = w0; *(u32x4*)(gp + 4) = w1; } }
    __syncthreads();
}
}
#define XB_TMO      128
#define XB_XCNT(j)  (256  + 64 * (j))
#define XB_XSUB(j)  (1280 + 64 * (j))
#define XB_XGEN(j)  (2304 + 64 * (j))
#define XB_TOP      3328
#define XB_TOPGEN   3392
#define XCD_BAR_WORDS 3456
#define XB_SPIN_CAP (1u << 18)
__device__ __forceinline__ unsigned xb_ld(unsigned* p)              { return __hip_atomic_load(p, __ATOMIC_RELAXED, __HIP_MEMORY_SCOPE_AGENT); }
__device__ __forceinline__ unsigned xb_add(unsigned* p, unsigned v) { return __hip_atomic_fetch_add(p, v, __ATOMIC_RELAXED, __HIP_MEMORY_SCOPE_AGENT); }
__device__ __forceinline__ unsigned xb_xcc_id() { return (unsigned)__builtin_amdgcn_s_getreg((3 << 11) | 20) & 0xFu; }
#define XB_SPIN(cond, bar) do { unsigned _sp = 0; while (cond) { __builtin_amdgcn_s_sleep(1); \
    if ((++_sp & 255u) == 0u) { if (xb_ld(&(bar)[XB_TMO])) break; if (_sp > XB_SPIN_CAP) { atomicAdd(&(bar)[XB_TMO], 1u); break; } } } } while (0)
struct XcdBarrier { unsigned* bar; unsigned x; volatile LAS unsigned* st; };
__device__ __forceinline__ XcdBarrier xcd_barrier_post(unsigned* bar, volatile LAS unsigned* st, bool t0) {
    XcdBarrier b; b.bar = bar; b.x = xb_xcc_id(); b.st = st;
    if (t0) (void)xb_add(&bar[XB_XCNT(b.x)], 1u);
    return b;
}
__device__ __forceinline__ void xcd_barrier_complete(unsigned* bar, unsigned x, unsigned& nloc, unsigned& nx) {
    const unsigned G = gridDim.x * gridDim.y * gridDim.z;
    unsigned sum, cnt, mine, sp = 0u;
    for (;;) {
        sum = 0u; cnt = 0u; mine = 0u;
#pragma unroll
        for (unsigned j = 0; j < 16; ++j) { const unsigned c = xb_ld(&bar[XB_XCNT(j)]); sum += c; cnt += (c > 0u) ? 1u : 0u; mine = (j == x) ? c : mine; }
        if (sum == G) break;
        __builtin_amdgcn_s_sleep(1);
        if ((++sp & 255u) == 0u) { if (xb_ld(&bar[XB_TMO])) break; if (sp > XB_SPIN_CAP) { atomicAdd(&bar[XB_TMO], 1u); break; } }
    }
    nloc = mine > 0u ? mine : 1u; nx = cnt > 0u ? cnt : 1u;
}
__device__ __forceinline__ void xcd_barrier_(const XcdBarrier& b, bool t0) {
    asm volatile("s_waitcnt vmcnt(0)" ::: "memory");
    __syncthreads();
    if (t0) {
        unsigned* bar = b.bar;
        __builtin_amdgcn_s_waitcnt(0);
        unsigned nloc = b.st[0], nx = b.st[1];
        if (nloc == 0u) { xcd_barrier_complete(bar, b.x, nloc, nx); b.st[0] = nloc; b.st[1] = nx; }
        const unsigned old = xb_add(&bar[XB_XSUB(b.x)], 1u);
        const unsigned gen = old / nloc;
        if (old + 1u == (gen + 1u) * nloc) {
            __builtin_amdgcn_fence(__ATOMIC_RELEASE, "agent");
            asm volatile("s_waitcnt vmcnt(0)" ::: "memory");
            const unsigned og = xb_add(&bar[XB_TOP], 1u);
            const unsigned tg = og / nx;
            if (og + 1u == (tg + 1u) * nx) xb_add(&bar[XB_TOPGEN], 1u);
            else XB_SPIN(xb_ld(&bar[XB_TOPGEN]) == tg, bar);
            __builtin_amdgcn_fence(__ATOMIC_ACQUIRE, "agent");
            xb_add(&bar[XB_XGEN(b.x)], 1u);
            asm volatile("s_waitcnt vmcnt(0)" ::: "memory");
        } else {
            XB_SPIN(xb_ld(&bar[XB_XGEN(b.x)]) == gen, bar);
            __builtin_amdgcn_fence(__ATOMIC_ACQUIRE, "agent");
            asm volatile("s_waitcnt vmcnt(0)" ::: "memory");
        }
    }
    __syncthreads();
}

constexpr int NWAVES = 8;
constexpr int RING_OFF = 0, RING_BYTES = 131072, MISC_OFF = RING_BYTES + 320, LUT_OFF = RING_BYTES + 9216  , LDS_BYTES = 147456;
#define LDS_WAIT() asm volatile("s_waitcnt lgkmcnt(0)" ::: "memory")

struct Args {
    const float *x, *mem, *ln_g, *w_in, *conv_w, *conv_b, *mem_ln_g, *w_mem_kv, *w_branch, *w_out, *final_g;
    float* out; unsigned char* ws; int ph_lo, ph_hi;
};

__device__ __forceinline__ float wave_sum(float v) {
#pragma unroll
    for (int o = 1; o < 64; o <<= 1) v += __shfl_xor(v, o);
    return v;
}
struct TrItem { const float* src; bf16_t* dst; int ldw, ldo; bool valid, f8; };
__device__ __forceinline__ void tr_load(const TrItem& it, f32x4 (&v)[16], int lane) {
    const float* p = it.src + (size_t)(lane >> 4) * it.ldw + (lane & 15) * 4;
#pragma unroll
    for (int i = 0; i < 16; ++i) v[i] = it.valid ? *(const f32x4*)(p + (size_t)(4 * i) * it.ldw) : (f32x4){0.f, 0.f, 0.f, 0.f};
}
__device__ __forceinline__ void tr_store(const TrItem& it, const f32x4 (&v)[16], LAS unsigned char* scr, int lane) {
    const int kr = lane >> 4, l16 = lane & 15;
#pragma unroll
    for (int i = 0; i < 16; ++i) *(LAS u32x2*)(scr + (4 * i + kr) * 128 + l16 * 8) = (u32x2){pk2(v[i].x, v[i].y), pk2(v[i].z, v[i].w)};
    asm volatile("s_waitcnt lgkmcnt(0)" ::: "memory");
    const int g = lane >> 4, q = (lane >> 2) & 3, p = lane & 3;
    const unsigned rb = (unsigned)(uintptr_t)scr + q * 128 + 32 * g + 8 * p;
    LAS unsigned char* ot = scr + 8192;
    const int nn = 16 * g + l16;
#pragma unroll
    for (int c = 0; c < 8; ++c) { u32x2 lo, hi;
        asm volatile("ds_read_b64_tr_b16 %0, %1 offset:%2" : "=&v"(lo) : "v"(rb), "i"(c * 1024) : "memory");
        asm volatile("ds_read_b64_tr_b16 %0, %1 offset:%2" : "=&v"(hi) : "v"(rb), "i"(c * 1024 + 512) : "memory");
        asm volatile("s_waitcnt lgkmcnt(0)" ::: "memory"); __builtin_amdgcn_sched_barrier(0);
        *(LAS u32x4*)(ot + nn * 128 + ((c ^ (nn & 7)) << 4)) = (u32x4){lo.x, lo.y, hi.x, hi.y}; }
    asm volatile("s_waitcnt lgkmcnt(0)" ::: "memory");
    const int cc = lane & 7;
#pragma unroll
    for (int j = 0; j < 8; ++j) { const int n2 = (lane >> 3) + 8 * j;
        const u32x4 v4 = *(const LAS u32x4*)(ot + n2 * 128 + ((cc ^ (n2 & 7)) << 4));
        if (it.f8) *(u32x2*)((unsigned char*)it.dst + (size_t)n2 * it.ldo + 8 * cc) = (u32x2){pk4f8(bflo(v4.x) * WSC, bfhi(v4.x) * WSC, bflo(v4.y) * WSC, bfhi(v4.y) * WSC), pk4f8(bflo(v4.z) * WSC, bfhi(v4.z) * WSC, bflo(v4.w) * WSC, bfhi(v4.w) * WSC)};
        else *(u32x4*)(it.dst + (size_t)n2 * it.ldo + 8 * cc) = v4; }
    asm volatile("s_waitcnt lgkmcnt(0)" ::: "memory");
}
__device__ __forceinline__ float wave_max(float v) {
#pragma unroll
    for (int o = 1; o < 64; o <<= 1) v = fmaxf(v, __shfl_xor(v, o));
    return v;
}
__device__ __forceinline__ unsigned q8x4(float a, float b, float c, float d) {
    const unsigned ua = __builtin_bit_cast(unsigned, a + 12582912.0f), ub = __builtin_bit_cast(unsigned, b + 12582912.0f), uc = __builtin_bit_cast(unsigned, c + 12582912.0f), ud = __builtin_bit_cast(unsigned, d + 12582912.0f);
    return (ua & 0xffu) | ((ub & 0xffu) << 8) | ((uc & 0xffu) << 16) | (ud << 24);
}
template <bool OUTF, int NR>
__device__ __forceinline__ void rms_rows(const float* xrow, size_t xstride, const float* g, void* orow, size_t ostride_bytes, int lane, unsigned char* q8row = nullptr, size_t q8stride = 0, float* sarow = nullptr, size_t sastride = 0) {
    f32x4 v[NR][8]; float s[NR];
#pragma unroll
    for (int r = 0; r < NR; ++r) { const f32x4* xr = (const f32x4*)(xrow + r * xstride) + lane;
#pragma unroll
        for (int j = 0; j < 8; ++j) v[r][j] = xr[64 * j]; }
    const f32x4* gr = (const f32x4*)g + lane;
    f32x4 gg8[8];
#pragma unroll
    for (int j = 0; j < 8; ++j) gg8[j] = gr[64 * j];
#pragma unroll
    for (int r = 0; r < NR; ++r) { float a = 0.f;
#pragma unroll
        for (int j = 0; j < 8; ++j) a += (v[r][j].x * v[r][j].x + v[r][j].y * v[r][j].y) + (v[r][j].z * v[r][j].z + v[r][j].w * v[r][j].w);
        s[r] = 1.0f / sqrtf(wave_sum(a) * (1.f / DM) + EPS); }
#pragma unroll
    for (int j = 0; j < 8; ++j) { const f32x4 gg = gg8[j];
#pragma unroll
        for (int r = 0; r < NR; ++r) { const f32x4 y = (f32x4){v[r][j].x * s[r] * gg.x, v[r][j].y * s[r] * gg.y, v[r][j].z * s[r] * gg.z, v[r][j].w * s[r] * gg.w};
            v[r][j] = y;
            unsigned char* ob = (unsigned char*)orow + r * ostride_bytes;
            if (OUTF) ((f32x4*)ob)[lane + 64 * j] = y;
            else ((u32x2*)ob)[lane + 64 * j] = (u32x2){pk2(y.x, y.y), pk2(y.z, y.w)}; } }
    if (!OUTF && q8row != nullptr) {
#pragma unroll
        for (int r = 0; r < NR; ++r) { float am = 0.f;
#pragma unroll
            for (int j = 0; j < 8; ++j) am = fmaxf(am, fmaxf(fmaxf(fabsf(v[r][j].x), fabsf(v[r][j].y)), fmaxf(fabsf(v[r][j].z), fabsf(v[r][j].w))));
            am = fmaxf(wave_max(am), 1e-30f);
            const float inv = 127.0f / am;
            unsigned* qb = (unsigned*)(q8row + r * q8stride);
#pragma unroll
            for (int j = 0; j < 8; ++j) qb[lane + 64 * j] = q8x4(v[r][j].x * inv, v[r][j].y * inv, v[r][j].z * inv, v[r][j].w * inv);
            if (lane == 0) sarow[r * sastride] = am * (1.0f / 127.0f); }
    }
}
template <bool OUTF>
__device__ __forceinline__ void rms_row(const float* xrow, const float* g, void* orow, int lane) { rms_rows<OUTF, 1>(xrow, 0, g, orow, 0, lane); }

__device__ __forceinline__ void kmean_pair(const bf16_t* PO, float* kmean, int u0, int u1, int wave, int lane, LAS float* red) {
    const int u = (wave < 4) ? u0 : u1, p = wave & 3, dg = lane & 15, rg = lane >> 4;
    float s[8] = {0.f, 0.f, 0.f, 0.f, 0.f, 0.f, 0.f, 0.f};
    if (u >= 0) {
        const int blk = u & 15, h = (u >> 4) & 7, b = u >> 7;
        const bf16_t* ptr = PO + (size_t)(b * SEQ + blk * 256 + p * 64 + rg) * NPO + C_AK + h * 128 + dg * 8;
        u32x4 w[16];
#pragma unroll
        for (int k = 0; k < 16; ++k) w[k] = *(const u32x4*)(ptr + (size_t)(4 * k) * NPO);
#pragma unroll
        for (int k = 0; k < 16; ++k) { s[0] += bflo(w[k].x); s[1] += bfhi(w[k].x); s[2] += bflo(w[k].y); s[3] += bfhi(w[k].y); s[4] += bflo(w[k].z); s[5] += bfhi(w[k].z); s[6] += bflo(w[k].w); s[7] += bfhi(w[k].w); }
#pragma unroll
        for (int i = 0; i < 8; ++i) { s[i] += __shfl_xor(s[i], 16); s[i] += __shfl_xor(s[i], 32); }
    }
    if (rg == 0) { LAS float* o = red + wave * 128 + dg * 8;
#pragma unroll
        for (int i = 0; i < 8; ++i) o[i] = s[i]; }
    __syncthreads();
    if (p == 0 && u >= 0 && rg < 2) {
        const int d4 = (lane & 31) * 4; const LAS float* r0 = red + wave * 128 + d4;
        f32x4 t = *(const LAS f32x4*)r0 + *(const LAS f32x4*)(r0 + 128) + *(const LAS f32x4*)(r0 + 256) + *(const LAS f32x4*)(r0 + 384);
        *(f32x4*)(kmean + (size_t)u * 128 + d4) = t * (1.0f / 256.0f); }
    __syncthreads();
}
__device__ __forceinline__ void mul8(const u32x4 a, const u32x4 b, float (&o)[8]) {
    o[0] = bflo(a.x) * bflo(b.x); o[1] = bfhi(a.x) * bfhi(b.x); o[2] = bflo(a.y) * bflo(b.y); o[3] = bfhi(a.y) * bfhi(b.y);
    o[4] = bflo(a.z) * bflo(b.z); o[5] = bfhi(a.z) * bfhi(b.z); o[6] = bflo(a.w) * bflo(b.w); o[7] = bfhi(a.w) * bfhi(b.w); }
__device__ __forceinline__ void conv_phase(const bf16_t* PO, const float* cw, const float* cbias, unsigned char* Y, int gtid, int nthr) {
    for (int it = gtid; it < M * 128; it += nthr) {
        const int t = it >> 7, c = (it & 127) * 8, pos = t & (SEQ - 1);
        const bf16_t* r0 = PO + (size_t)t * NPO;
        float u2[8], u1[8], u0[8], bg[8];
        mul8(*(const u32x4*)(r0 + C_CC + c), *(const u32x4*)(r0 + C_CH + c), u2);
        if (pos >= 1) mul8(*(const u32x4*)(r0 - NPO + C_CC + c), *(const u32x4*)(r0 - NPO + C_CH + c), u1); else { for (int i = 0; i < 8; ++i) u1[i] = 0.f; }
        if (pos >= 2) mul8(*(const u32x4*)(r0 - 2 * (size_t)NPO + C_CC + c), *(const u32x4*)(r0 - 2 * (size_t)NPO + C_CH + c), u0); else { for (int i = 0; i < 8; ++i) u0[i] = 0.f; }
        mul8(*(const u32x4*)(r0 + C_CB + c), *(const u32x4*)(r0 + C_CG + c), bg);
        float y[8];
#pragma unroll
        for (int i = 0; i < 8; ++i) y[i] = (cw[c + i] * u0[i] + cw[BW + c + i] * u1[i] + cw[2 * BW + c + i] * u2[i] + cbias[c + i]) * bg[i];
        *(u32x4*)(Y + (size_t)t * YB + 3072 + 2 * c) = (u32x4){pk2(y[0], y[1]), pk2(y[2], y[3]), pk2(y[4], y[5]), pk2(y[6], y[7])};
    }
}
__device__ __forceinline__ void quant_strip(const float* __restrict__ src, unsigned char* __restrict__ w8, float* __restrict__ sb, LAS unsigned char* img, LAS float* red, int wave, int lane, int nvalid) {
    constexpr int SP = 4100;
    const int rp = lane >> 3, c4 = lane & 7;
    const float* p = src + (size_t)(256 * wave + 2 * rp) * NIN + 4 * c4;
    f32x4 e[16], o[16];
    const bool cv = (4 * c4 < nvalid);
#pragma unroll
    for (int i = 0; i < 16; ++i) { const float* q = p + (size_t)(16 * i) * NIN; e[i] = cv ? *(const f32x4*)q : (f32x4){0.f, 0.f, 0.f, 0.f}; o[i] = cv ? *(const f32x4*)(q + NIN) : (f32x4){0.f, 0.f, 0.f, 0.f}; }
    float am[4] = {0.f, 0.f, 0.f, 0.f};
    LAS unsigned char* wb = img + (4 * c4) * SP + (256 * wave + 2 * rp) * 2;
#pragma unroll
    for (int i = 0; i < 16; ++i)
#pragma unroll
        for (int c = 0; c < 4; ++c) { am[c] = fmaxf(am[c], fmaxf(fabsf(e[i][c]), fabsf(o[i][c]))); *(LAS unsigned*)(wb + c * SP + 32 * i) = pk2(e[i][c], o[i][c]); }
#pragma unroll
    for (int c = 0; c < 4; ++c) { am[c] = fmaxf(am[c], __shfl_xor(am[c], 8)); am[c] = fmaxf(am[c], __shfl_xor(am[c], 16)); am[c] = fmaxf(am[c], __shfl_xor(am[c], 32)); }
    if (rp == 0) { *(LAS f32x4*)(red + wave * 32 + 4 * c4) = (f32x4){am[0], am[1], am[2], am[3]}; }
    asm volatile("s_waitcnt lgkmcnt(0)" ::: "memory");
    __syncthreads();
#pragma unroll
    for (int i = 0; i < 4; ++i) { const int n = 4 * wave + i;
        float m = red[n];
#pragma unroll
        for (int w2 = 1; w2 < 8; ++w2) m = fmaxf(m, red[w2 * 32 + n]);
        m = fmaxf(m, 1e-30f); const float inv = 127.0f / m;
        const LAS unsigned* rd = (const LAS unsigned*)(img + n * SP + lane * 64);
        unsigned x[16];
#pragma unroll
        for (int d = 0; d < 16; ++d) x[d] = rd[d];
        u32x4 q0, q1;
        q0.x = q8x4(bflo(x[0]) * inv, bfhi(x[0]) * inv, bflo(x[1]) * inv, bfhi(x[1]) * inv); q0.y = q8x4(bflo(x[2]) * inv, bfhi(x[2]) * inv, bflo(x[3]) * inv, bfhi(x[3]) * inv);
        q0.z = q8x4(bflo(x[4]) * inv, bfhi(x[4]) * inv, bflo(x[5]) * inv, bfhi(x[5]) * inv); q0.w = q8x4(bflo(x[6]) * inv, bfhi(x[6]) * inv, bflo(x[7]) * inv, bfhi(x[7]) * inv);
        q1.x = q8x4(bflo(x[8]) * inv, bfhi(x[8]) * inv, bflo(x[9]) * inv, bfhi(x[9]) * inv); q1.y = q8x4(bflo(x[10]) * inv, bfhi(x[10]) * inv, bflo(x[11]) * inv, bfhi(x[11]) * inv);
        q1.z = q8x4(bflo(x[12]) * inv, bfhi(x[12]) * inv, bflo(x[13]) * inv, bfhi(x[13]) * inv); q1.w = q8x4(bflo(x[14]) * inv, bfhi(x[14]) * inv, bflo(x[15]) * inv, bfhi(x[15]) * inv);
        u32x4* dst = (u32x4*)(w8 + (size_t)n * W8P + lane * 32);
        dst[0] = q0; dst[1] = q1;
        if (lane == 0) sb[n] = m * (1.0f / 127.0f); }
    asm volatile("s_waitcnt lgkmcnt(0)" ::: "memory");
    __syncthreads();
}
typedef const __attribute__((address_space(4))) Args CArgs;
#define PH_BEGIN() CArgs* ap = (CArgs*)__builtin_amdgcn_kernarg_segment_ptr(); asm volatile("" : "+s"(ap)); unsigned char* const ws = ap->ws; \
    int pt = wave * 64 + lane_id_v(); asm volatile("" : "+v"(pt)); const int lane = pt & 63; (void)lane; \
    const int G = gridDim.x, bx = blockIdx.x; (void)G; (void)bx
__global__ void __launch_bounds__(NWAVES * 64, 2) fwd(Args a) {
    extern __shared__ __attribute__((aligned(16))) unsigned char lds_raw[];
    LAS unsigned char* lds = (LAS unsigned char*)lds_raw;
    const int wave = __builtin_amdgcn_readfirstlane((int)threadIdx.x >> 6);
    const int lo = a.ph_lo, hi = a.ph_hi;
    volatile LAS unsigned* MISC = (volatile LAS unsigned*)(lds + MISC_OFF);
    if (threadIdx.x < 32) MISC[threadIdx.x] = 0u;
    for (int i = threadIdx.x; i < 4096; i += NWAVES * 64) lds[LUT_OFF + i] = (unsigned char)(unsigned)(255.0f / (1.0f + __expf(-(float)(i - 2048) * (1.0f / 256.0f))) + 0.5f);
    __syncthreads();
    XcdBarrier bar; bar.bar = (unsigned*)(a.ws + WS_CTL); bar.x = 0; bar.st = nullptr;
    if (hi - lo > 1) bar = xcd_barrier_post((unsigned*)(a.ws + WS_CTL), MISC + 8, threadIdx.x == 0);
#define xcd_barrier(b) xcd_barrier_(b, wave == 0 && lane_id_v() == 0)
#define BOTH(k) (IN(k) && IN((k) + 1))
#define IN(k) (lo <= (k) && (k) < hi)
#define VCU() ((G % 8 == 0) ? (bx % 8) * (G / 8) + bx / 8 : bx)
#ifndef PROBE_REP
#define PROBE_REP -1
#endif
#define NREP(k) ((PROBE_REP == (k)) ? 2 : 1)
#if defined(PROBE_MFMA)
    {
        const unsigned lz = (unsigned)lane_id_v() * 2654435761u + 12345u;
        i32x4 pa = {(int)(lz * 3u), (int)(lz * 5u + 7u), (int)(lz * 7u + 1u), (int)(lz * 11u + 3u)}, pb = {(int)(lz * 13u), (int)(lz * 17u + 7u), (int)(lz * 19u + 1u), (int)(lz * 23u + 3u)};
        pa &= 0x3f3f3f3f; pb &= 0x3f3f3f3f;
        f32x4 pd[8];
#pragma unroll
        for (int j = 0; j < 8; ++j) pd[j] = (f32x4){0.f, 0.f, 0.f, 0.f};
        const i32x8 pa8 = __builtin_shufflevector(pa, pb, 0, 1, 2, 3, 4, 5, 6, 7), pb8 = __builtin_shufflevector(pb, pa, 0, 1, 2, 3, 4, 5, 6, 7);
#pragma unroll 1
        for (int i = 0; i < 4000; ++i) {
#pragma unroll
            for (int j = 0; j < 8; ++j) {
                if (PROBE_MFMA == 1) pd[j] = __builtin_amdgcn_mfma_f32_16x16x32_bf16(__builtin_bit_cast(bf16x8, pa), __builtin_bit_cast(bf16x8, pb), pd[j], 0, 0, 0);
                else if (PROBE_MFMA == 2) pd[j] = __builtin_bit_cast(f32x4, __builtin_amdgcn_mfma_i32_16x16x64_i8(pa, pb, __builtin_bit_cast(i32x4, pd[j]), 0, 0, 0));
                else if (PROBE_MFMA == 3) { if (j < 4) pd[j] = __builtin_amdgcn_mfma_scale_f32_16x16x128_f8f6f4(pa8, pb8, pd[j], 0, 0, 0, 0, 0, 0); }
            }
        }
        float ps = 0.f;
#pragma unroll
        for (int j = 0; j < 8; ++j) ps += pd[j][0] + pd[j][1] + pd[j][2] + pd[j][3];
        if (ps == 1.2345678f) ((float*)(a.ws + WS_CTL))[200000] = ps;
    }
#endif
    for (int rep = 0; rep < NREP(100); ++rep) if (IN(0)) {
        PH_BEGIN();
        LAS unsigned char* scr = lds + RING_OFF + wave * 16384;
        const int gw = VCU() * NWAVES + wave, NGW = G * NWAVES;
        { const int xcd = bx & 7, tq = bx >> 3, pos = 8 * (xcd + 8 * (tq >> 3)) + (tq & 7);
          constexpr int NST = 8 * NI8;
          for (int sidx = pos; sidx < 2 * NST; sidx += 256) { const int L = sidx / NST, st = sidx % NST, t8 = st >> 3, t = i8_tile(t8), n0 = t * 256 + (st & 7) * 32, srcn = (n0 >= 14848) ? n0 - 188 : n0;
              const int nv = (n0 >= 14848) ? 32 : (14660 - n0 < 0 ? 0 : (14660 - n0 > 32 ? 32 : 14660 - n0));
              quant_strip(ap->w_in + (size_t)L * DM * NIN + srcn, ws + WS_W8 + L * SZ_W8 + (size_t)n0 * W8P, (float*)(ws + WS_SB) + L * NP + n0, lds, (LAS float*)(lds + RING_BYTES + 1024), wave, lane, nv); } }
        constexpr int NBB = 4 * NBF  , I_IN = (DM / 64) * NBB, I_KV = (DM / 64) * (2048 / 64), I_BR = (BW / 64) * (DM / 64), I_OUT = (DM / 64) * (DM / 64);
        constexpr int PER_L = I_IN + I_KV + 4 * I_BR + I_OUT;
        auto decode = [&](int it) -> TrItem {
            TrItem t; const int L = it / PER_L; int r = it % PER_L; t.f8 = false;
            if (r < I_IN) { const int kb = r / NBB, nbi = r % NBB, n0 = 256 * bf_tile(nbi >> 2) + 64 * (nbi & 3);
                t.src = ap->w_in + (size_t)L * DM * NIN + (size_t)(64 * kb) * NIN + n0; t.ldw = NIN; t.ldo = WKP; t.dst = (bf16_t*)(ws + WS_WIN + L * SZ_WIN) + (size_t)n0 * WKP + 64 * kb;
                t.valid = (n0 + (lane & 15) * 4 < 14660); return t; }
            r -= I_IN;
            if (r < I_KV) { const int nblk = 2048 / 64, kb = r / nblk, nb = r % nblk;
                t.src = ap->w_mem_kv + (size_t)L * DM * 2048 + (size_t)(64 * kb) * 2048 + 64 * nb; t.ldw = 2048; t.ldo = WKP; t.dst = (bf16_t*)(ws + WS_WKV + L * SZ_WKV) + (size_t)(64 * nb) * WKP + 64 * kb; t.valid = true; return t; }
            r -= I_KV;
            if (r < 4 * I_BR) { const int z = r / I_BR, rr = r % I_BR, nblk = DM / 64, kb = rr / nblk, nb = rr % nblk;
                t.src = ap->w_branch + ((size_t)L * 4 + z) * BW * DM + (size_t)(64 * kb) * DM + 64 * nb; t.ldw = DM; t.valid = true;
                if (z == 1) { t.ldo = WBP; t.dst = (bf16_t*)(ws + WS_WBR + L * SZ_WBR) + (size_t)z * DM * WBP + (size_t)(64 * nb) * WBP + 64 * kb; }
                else { const int slot = (z == 0) ? 0 : z - 1; t.f8 = true; t.ldo = WBP * 2; t.dst = (bf16_t*)(ws + WS_WB8 + L * SZ_WB8 + ((size_t)slot * DM + 64 * nb) * (WBP * 2) + 64 * kb); }
                return t; }
            r -= 4 * I_BR;
            { const int nblk = DM / 64, kb = r / nblk, nb = r % nblk;
              t.src = ap->w_out + (size_t)L * DM * DM + (size_t)(64 * kb) * DM + 64 * nb; t.ldw = DM; t.ldo = WKP; t.dst = (bf16_t*)(ws + WS_WOUT + L * SZ_WOUT) + (size_t)(64 * nb) * WKP + 64 * kb; t.valid = true; return t; }
        };
        {
            f32x4 va[16], vb[16];
            int it = gw;
            TrItem ta = decode(it < 2 * PER_L ? it : 0), tb = ta;
            if (it < 2 * PER_L) tr_load(ta, va, lane);
            for (; it < 2 * PER_L; it += 2 * NGW) {
                const bool hb = (it + NGW < 2 * PER_L);
                if (hb) { tb = decode(it + NGW); tr_load(tb, vb, lane); }
                tr_store(ta, va, scr, lane);
                if (it + 2 * NGW < 2 * PER_L) { ta = decode(it + 2 * NGW); tr_load(ta, va, lane); }
                if (hb) tr_store(tb, vb, scr, lane);
            }
        }
        if (M % (2 * NGW) == 0) { for (int m = gw; m < M; m += 2 * NGW) rms_rows<false, 2>(ap->x + (size_t)m * DM, (size_t)NGW * DM, ap->ln_g, (bf16_t*)(ws + WS_XN) + (size_t)m * XNP, (size_t)NGW * XNP * 2, lane, ws + WS_XN8 + (size_t)m * XN8P, (size_t)NGW * XN8P, (float*)(ws + WS_SA) + m, (size_t)NGW); }
        else { for (int m = gw; m < M; m += NGW) rms_rows<false, 1>(ap->x + (size_t)m * DM, 0, ap->ln_g, (bf16_t*)(ws + WS_XN) + (size_t)m * XNP, 0, lane, ws + WS_XN8 + (size_t)m * XN8P, 0, (float*)(ws + WS_SA) + m, 0); }
        for (int m = gw; m < 2 * 1024; m += NGW) { const int L = m / 1024, r = m % 1024;
            rms_row<false>(ap->mem + (size_t)r * DM, ap->mem_ln_g + L * DM, (bf16_t*)(ws + WS_MEMN) + (size_t)m * WKP, lane); }
        if (BOTH(0)) xcd_barrier(bar);
    }
    if (IN(1)) {
        PH_BEGIN();
        { pg8::Gemm g{(const bf16_t*)(ws + WS_MEMN), (const bf16_t*)(ws + WS_WKV), DM, WKP, WKP, (size_t)1024 * WKP * 2, SZ_WKV, 0};
          pg8::Sched S{4, 4, 2, 0, G, (bx + 96) % G}; pg8::EpiBf16 E{(bf16_t*)(ws + WS_MK), 1024, (size_t)1024 * 1024};
          pg8::gemm_phase<pg8::EpiBf16, true>(lds + RING_OFF, g, S, E, wave); }
        { pg8::Gemm g{(const bf16_t*)(ws + WS_WKV) + (size_t)1024 * WKP, (const bf16_t*)(ws + WS_MEMN), DM, WKP, WKP, SZ_WKV, (size_t)1024 * WKP * 2, 0};
          pg8::Sched S{4, 4, 2, 0, G, (bx + 128) % G}; pg8::EpiBf16 E{(bf16_t*)(ws + WS_VT), 1024, (size_t)1024 * 1024};
          pg8::gemm_phase<pg8::EpiBf16, true>(lds + RING_OFF, g, S, E, wave); }
    }
#pragma unroll 1
    for (int L = 0; L < 2; ++L) {
        const int pb = 2 + 6 * L;
        for (int rep = 0; rep < NREP(0); ++rep) if (IN(pb + 0)) {
            PH_BEGIN();
            for (int r9 = 0; r9 < NREP(9); ++r9) { pg8::Gemm g{(const bf16_t*)(ws + WS_XN8), (const bf16_t*)(ws + WS_W8 + L * SZ_W8), DM / 2, XN8P / 2, W8P / 2, 0, 0, 0};
              pg8::Sched S{M / 256, NI8, 1, 0, G, bx, 1, (L == 1 && G == 256 && NI8 == 88) ? 21 : 0};
              pg8::EpiInProj<true> E{(bf16_t*)(ws + WS_PO), (float*)(ws + WS_IDX), (bf16_t*)(ws + WS_IQC), (bf16_t*)(ws + WS_IKC), ws + WS_G8, (const float*)(ws + WS_SA), (const float*)(ws + WS_SB) + L * NP, (const LAS unsigned char*)(lds + LUT_OFF), (LAS float*)(lds + RING_BYTES + 1024)};
              pg8::gemm_phase<pg8::EpiInProj<true>, true, 1>(lds + RING_OFF, g, S, E, wave, r9 > 0); }
            for (int r10 = 0; r10 < NREP(10); ++r10) { PH_BEGIN();
              pg8::Gemm g{(const bf16_t*)(ws + WS_XN), (const bf16_t*)(ws + WS_WIN + L * SZ_WIN), DM, XNP, WKP, 0, 0, 0};
              pg8::Sched S{M / 256, NBF, 1, 0, G, bx, 2};
              pg8::EpiInProj<false> E{(bf16_t*)(ws + WS_PO), (float*)(ws + WS_IDX), (bf16_t*)(ws + WS_IQC), (bf16_t*)(ws + WS_IKC), ws + WS_G8, nullptr, nullptr, nullptr, nullptr};
              pg8::gemm_phase<pg8::EpiInProj<false>, true, 0>(lds + RING_OFF, g, S, E, wave); }
            if (BOTH(pb + 0)) xcd_barrier(bar);
        }
        for (int rep = 0; rep < NREP(1); ++rep) if (IN(pb + 1)) {
            { PH_BEGIN(); const bf16_t* PO = (const bf16_t*)(ws + WS_PO);
              const int gw = VCU() * NWAVES + wave, NGW = G * NWAVES;
              for (int u = 2 * bx; u < 512; u += 2 * G) kmean_pair(PO, (float*)(ws + WS_KMEAN), u, (u + 1 < 512) ? u + 1 : -1, wave, lane, (LAS float*)(lds + RING_OFF));
              for (int r8 = 0; r8 < NREP(8); ++r8) conv_phase(PO, ap->conv_w + (size_t)L * 3 * BW, ap->conv_b + (size_t)L * BW, ws + WS_Y, bx * 512 + pt, G * 512); }
            for (int r7 = 0; r7 < NREP(7); ++r7) { PH_BEGIN(); pg8::Gemm g{(const bf16_t*)(ws + WS_PO) + C_MQ, (const bf16_t*)(ws + WS_MK) + (size_t)L * 1024 * 1024, 256, NPO, 1024, 512, 512, (size_t)256 * 1024 * 2};
              pg8::Sched S{M / 256, 1, 4, 0, G, bx}; pg8::EpiSoftmax E{(bf16_t*)(ws + WS_PM), (LAS float*)(lds + RING_BYTES + 1024)};
              pg8::gemm_phase<pg8::EpiSoftmax, true>(lds + RING_OFF, g, S, E, wave); }
            __syncthreads();
            { PH_BEGIN(); const bf16_t* IQC = (const bf16_t*)(ws + WS_IQC); const bf16_t* IKC = (const bf16_t*)(ws + WS_IKC); const float* IDX = (const float*)(ws + WS_IDX); unsigned* maskw = (unsigned*)(ws + WS_MASK);
              for (int r6 = 0; r6 < NREP(6); ++r6) for (int v = bx; v < 256; v += G) { const int tb = v >> 6, ti = v & 63; unsigned* scr = (unsigned*)(ws + WS_SCR) + (size_t)bx * (512 * 1024 / 4); for (int hh2 = 0; hh2 < 2; ++hh2) { const int uu = hh2 ? ti : 127 - ti; tk::topk_unit(IQC, IKC, IDX, maskw, scr, tb, uu, (LAS char*)lds, wave);
#ifdef TK_CHECK
                  { unsigned* maskw2 = (unsigned*)(ws + WS_MASK2); tk::topk_unit(IQC, IKC, IDX, maskw2, scr, tb, uu, (LAS char*)lds, wave, 1);
                    const int q = pt >> 4, c = pt & 15;
                    if (c <= (uu >> 3)) { const size_t o = ((size_t)tb * SEQ + uu * 32 + q) * 128 + 8 * c; bool bad = false;
                        for (int e = 0; e < 8; ++e) bad |= (maskw[o + e] != maskw2[o + e]);
                        if (bad) __hip_atomic_fetch_or((unsigned*)(ws + WS_CTL) + 12000, 1u, __ATOMIC_RELAXED, __HIP_MEMORY_SCOPE_AGENT); } }
#endif
              } } }
            if (BOTH(pb + 1)) xcd_barrier(bar);
        }
        for (int rep = 0; rep < NREP(2); ++rep) if (IN(pb + 2)) {
            { PH_BEGIN(); pg8::Gemm g{(const bf16_t*)(ws + WS_PM), (const bf16_t*)(ws + WS_VT) + (size_t)L * 1024 * 1024, 256, 1024, 1024, 512, (size_t)256 * 1024 * 2, 512};
              pg8::Sched S{M / 256, 1, 4, 0, G, bx}; pg8::EpiMemOut E{(const bf16_t*)(ws + WS_PO), ws + WS_Y};
              pg8::gemm_phase<pg8::EpiMemOut, true>(lds + RING_OFF, g, S, E, wave); }
            for (;;) {
                PH_BEGIN(); const bf16_t* PO = (const bf16_t*)(ws + WS_PO); unsigned char* Y = ws + WS_Y;
                if (pt == 0) MISC[4] = __hip_atomic_fetch_add((unsigned*)(ws + WS_CTL) + 8192 + 64 * L + 256 * rep, 1u, __ATOMIC_RELAXED, __HIP_MEMORY_SCOPE_AGENT);
                __syncthreads();
                const unsigned u = MISC[4];
                __syncthreads();
                if (u >= 1024u) break;
                const int qb = 15 - (int)(u >> 6), mode = (u >> 5) & 1, bb = (u >> 3) & 3, hh = u & 7;
                const size_t tok0 = (size_t)bb * SEQ + (size_t)qb * 256;
                if (mode == 0) att::attn_unit<0>(PO + tok0 * NPO + C_AQ + hh * 128, PO + (size_t)bb * SEQ * NPO + C_AK + hh * 128, PO + (size_t)bb * SEQ * NPO + C_AV + hh * 128, PO + tok0 * NPO + C_AG + hh * 128,
                                                 Y + tok0 * YB + hh * 128, (const float*)(ws + WS_KMEAN) + (size_t)(bb * 8 + hh) * 16 * 128, nullptr, qb, (LAS char*)lds, wave);
                else att::attn_unit<1>(PO + tok0 * NPO + C_SQ + hh * 128, PO + (size_t)bb * SEQ * NPO + C_SK + hh * 128, PO + (size_t)bb * SEQ * NPO + C_SV + hh * 128, PO + tok0 * NPO + C_SG + hh * 128,
                                       Y + tok0 * YB + 1024 + hh * 128, nullptr, (const unsigned*)(ws + WS_MASK) + tok0 * 128, qb, (LAS char*)lds, wave);
            }
            if (BOTH(pb + 2)) xcd_barrier(bar);
        }
        for (int rep = 0; rep < NREP(3); ++rep) if (IN(pb + 3)) {
            PH_BEGIN();
            for (int r11 = 0; r11 < NREP(11); ++r11) { pg8::Gemm g{(const bf16_t*)(ws + WS_Y + 3072), (const bf16_t*)(ws + WS_WBR + L * SZ_WBR) + (size_t)DM * WBP, BW, YB / 2, WBP, 0, 0, 0};
              pg8::Sched S{M / 256, DM / 256, 1, 0, G, bx};
              pg8::EpiMergeC E{(bf16_t*)(ws + WS_PO), ws + WS_G8};
              pg8::gemm_phase<pg8::EpiMergeC, true, 0>(lds + RING_OFF, g, S, E, wave); }
            for (int r12 = 0; r12 < NREP(12); ++r12) { PH_BEGIN();
              pg8::Gemm g{(const bf16_t*)(ws + WS_Y), (const bf16_t*)(ws + WS_WB8 + L * SZ_WB8), BW / 2, YB / 2, WBP, (size_t)BW, (size_t)DM * WBP * 2, 0};
              pg8::Sched S{M / 256, DM / 256, 3, 1, G, bx};
              pg8::EpiMerge E{(bf16_t*)(ws + WS_PO), ws + WS_G8};
              pg8::gemm_phase<pg8::EpiMerge, true, 2>(lds + RING_OFF, g, S, E, wave); }
            if (BOTH(pb + 3)) xcd_barrier(bar);
        }
        for (int rep = 0; rep < ((L == 0) ? NREP(4) : 1); ++rep) if (IN(pb + 4)) {
            PH_BEGIN();
            pg8::Gemm g{(const bf16_t*)(ws + WS_PO) + 4096, (const bf16_t*)(ws + WS_WOUT + L * SZ_WOUT), DM, NPO, WKP, 0, 0, 0};
            pg8::Sched S{M / 256, DM / 256, 1, 0, G, bx};
            pg8::EpiOut E{L == 0 ? ap->x : ap->out, ap->out};
            pg8::gemm_phase<pg8::EpiOut, true>(lds + RING_OFF, g, S, E, wave);
            if (BOTH(pb + 4)) xcd_barrier(bar);
        }
        for (int rep = 0; rep < ((L == 0) ? NREP(5) : 1); ++rep) if (IN(pb + 5)) {
            PH_BEGIN();
            const int gw = VCU() * NWAVES + wave, NGW = G * NWAVES; float* out = ap->out;
            if (M % (2 * NGW) != 0) { if (L == 0) { for (int m = gw; m < M; m += NGW) rms_rows<false, 1>(out + (size_t)m * DM, 0, ap->ln_g + DM, (bf16_t*)(ws + WS_XN) + (size_t)m * XNP, 0, lane, ws + WS_XN8 + (size_t)m * XN8P, 0, (float*)(ws + WS_SA) + m, 0); } else { for (int m = gw; m < M; m += NGW) rms_row<true>(out + (size_t)m * DM, ap->final_g, out + (size_t)m * DM, lane); } }
            else if (L == 0) { for (int m = gw; m < M; m += 2 * NGW) rms_rows<false, 2>(out + (size_t)m * DM, (size_t)NGW * DM, ap->ln_g + DM, (bf16_t*)(ws + WS_XN) + (size_t)m * XNP, (size_t)NGW * XNP * 2, lane, ws + WS_XN8 + (size_t)m * XN8P, (size_t)NGW * XN8P, (float*)(ws + WS_SA) + m, (size_t)NGW); }
            else { for (int m = gw; m < M; m += 2 * NGW) rms_rows<true, 2>(out + (size_t)m * DM, (size_t)NGW * DM, ap->final_g, out + (size_t)m * DM, (size_t)NGW * DM * 4, lane); }
#ifdef TK_CHECK
            if (L == 1 && gw == 0 && lane == 0 && __hip_atomic_load((unsigned*)(ws + WS_CTL) + 12000, __ATOMIC_RELAXED, __HIP_MEMORY_SCOPE_AGENT) != 0u) { asm volatile("s_waitcnt vmcnt(0)" ::: "memory"); out[0] = __builtin_nanf(""); }
#endif
            if (L == 0 && BOTH(pb + 5)) xcd_barrier(bar);
        }
    }
#undef IN
#undef BOTH
}

extern "C" void kernel_launch(void* const* d_in, const int* in_sizes, int n_in, void* d_out, int out_size, void* d_ws, size_t ws_size, hipStream_t stream) {
    static int grid = 0;
    if (grid == 0) {
        if (n_in != 11 || out_size != M * DM || ws_size < WS_END + 16 * MiB) { fprintf(stderr, "kernel_launch: unexpected shapes (n_in %d out %d ws %zu need %zu)\n", n_in, out_size, ws_size, (size_t)WS_END); grid = -1; return; }
        int dev = 0, cus = 0;
        if (hipGetDevice(&dev) != hipSuccess || hipDeviceGetAttribute(&cus, hipDeviceAttributeMultiprocessorCount, dev) != hipSuccess) { grid = -1; return; }
        if (hipFuncSetAttribute((const void*)fwd, hipFuncAttributeMaxDynamicSharedMemorySize, LDS_BYTES) != hipSuccess) { fprintf(stderr, "kernel_launch: hipFuncSetAttribute failed\n"); grid = -1; return; }
        grid = cus;
    }
    if (grid < 0) return;
    Args a{};
    a.x = (const float*)d_in[0]; a.mem = (const float*)d_in[1]; a.ln_g = (const float*)d_in[2]; a.w_in = (const float*)d_in[3]; a.conv_w = (const float*)d_in[4]; a.conv_b = (const float*)d_in[5];
    a.mem_ln_g = (const float*)d_in[6]; a.w_mem_kv = (const float*)d_in[7]; a.w_branch = (const float*)d_in[8]; a.w_out = (const float*)d_in[9]; a.final_g = (const float*)d_in[10];
    a.out = (float*)d_out; a.ws = (unsigned char*)d_ws;
    unsigned char* ws = (unsigned char*)d_ws;
    if (hipMemsetAsync(ws + WS_CTL, 0, 65536, stream) != hipSuccess) { fprintf(stderr, "kernel_launch: memset failed\n"); return; }
    a.ph_lo = 0; a.ph_hi = 14;
    hipLaunchKernelGGL(fwd, dim3(grid), dim3(NWAVES * 64), LDS_BYTES, stream, a);
    const hipError_t le = hipPeekAtLastError();
    if (le != hipSuccess) fprintf(stderr, "kernel_launch: launch failed: %s\n", hipGetErrorName(le));
}
```

```cpp
#include <hip/hip_runtime.h>
#include <cstdio>
#include <cstdint>

#define LAS __attribute__((address_space(3)))
#define GAS __attribute__((address_space(1)))
typedef unsigned short bf16_t;
typedef short bf16x8 __attribute__((ext_vector_type(8)));
typedef float f32x4 __attribute__((ext_vector_type(4)));
typedef float f32x2 __attribute__((ext_vector_type(2)));
typedef unsigned u32x4 __attribute__((ext_vector_type(4)));
typedef unsigned u32x2 __attribute__((ext_vector_type(2)));
typedef int i32x4 __attribute__((ext_vector_type(4)));
typedef int i32x8 __attribute__((ext_vector_type(8)));

constexpr int DM = 2048, NB = 4, SEQ = 4096, M = NB * SEQ, MEML = 256, BW = 1024;
constexpr int NIN = 22852, NP = 23040, NPO = 14848;
constexpr float EPS = 1e-6f;
constexpr int BF_LO = 16, BF_HI = 16, NBC = BF_HI - BF_LO, NBF = NBC + 2, NI8 = 90 - NBF;
__host__ __device__ constexpr int i8_tile(int i) { return i < BF_LO ? i : (i + NBC < 56 ? i + NBC : i + NBC + 2); }
__host__ __device__ constexpr int bf_tile(int i) { return i < NBC ? BF_LO + i : 56 + (i - NBC); }
__host__ __device__ constexpr bool is_f4(int t) { return (t >= 58 && t < 66) || t >= 74; }
__host__ __device__ constexpr int f4_index(int t) { return t < 66 ? t - 58 : t - 66; }
__host__ __device__ constexpr int f4_tile(int i) { return i < 8 ? 58 + i : 66 + i; }
__host__ __device__ constexpr int i8g_tile(int i) { return i < 8 ? i : (i < 36 ? i + 4 : (i < 48 ? i + 8 : i + 18)); }
__host__ __device__ constexpr int vt_tile(int i) { return i < 4 ? 8 + i : 36 + i; }
static_assert(BF_LO == 16 && BF_HI == 16, "i8g_tile assumes every conv tile is in the int8 group");
constexpr int XNP = 2112, YB = 5248, WKP = 2112, WBP = 1088;
constexpr int C_AQ = 0, C_AK = 1024, C_AV = 2048, C_AG = 3072, C_CB = 4096, C_CC = 5120, C_CH = 6144, C_CG = 7168;
constexpr int C_SQ = 8192, C_SK = 9216, C_SV = 10240, C_SG = 11264, C_MQ = 12288, C_MG = 13312, C_IDX = 14336, C_R = 14848;
constexpr size_t MiB = 1u << 20;
constexpr size_t WS_CTL = 0, CTL_BYTES = 1 * MiB;
constexpr size_t SZ_WIN = (size_t)NP * WKP * 2, SZ_WKV = (size_t)2048 * WKP * 2, SZ_WBR = (size_t)4 * DM * WBP * 2, SZ_WOUT = (size_t)DM * WKP * 2;
constexpr size_t WS_WIN = 1 * MiB;
constexpr size_t WS_WKV = WS_WIN + 2 * SZ_WIN;
constexpr size_t WS_WBR = WS_WKV + 2 * SZ_WKV;
constexpr size_t WS_WOUT = WS_WBR + 2 * SZ_WBR;
constexpr size_t WS_XN = WS_WOUT + 2 * SZ_WOUT;
constexpr size_t WS_MEMN = WS_XN + (size_t)M * XNP * 2;
constexpr size_t WS_KVM = WS_MEMN + 2 * (size_t)1024 * WKP * 2;
constexpr size_t WS_PO = WS_KVM + 2 * (size_t)1024 * 2048 * 2;
constexpr size_t WS_IDX = WS_PO + (size_t)M * NPO * 2;
constexpr size_t WS_Y = WS_IDX + (size_t)M * 4 * 4;
constexpr size_t WS_MASK = WS_Y + (size_t)M * YB;
constexpr size_t WS_KMEAN = WS_MASK + (size_t)4 * 128 * 4096 * 4;
constexpr size_t WS_PM = WS_KMEAN + (size_t)4 * 8 * 16 * 128 * 4;
constexpr size_t WS_SCR = WS_PM + (size_t)M * 1024 * 2;
constexpr size_t WS_IQC = WS_SCR + (size_t)256 * 512 * 1024;
constexpr size_t WS_IKC = WS_IQC + (size_t)M * 256 * 2;
constexpr size_t WS_G8 = WS_IKC + (size_t)M * 64 * 2;
constexpr int XN8P = 2176, W8P = 2176;
constexpr size_t WS_XN8 = WS_G8 + (size_t)M * 8192;
constexpr size_t WS_SA = WS_XN8 + (size_t)M * XN8P;
constexpr size_t WS_W8 = WS_SA + (size_t)M * 4;
constexpr size_t SZ_W8 = (size_t)NP * W8P;
constexpr size_t WS_SB = WS_W8 + 2 * SZ_W8;
constexpr size_t WS_WB8 = WS_SB + 2 * (size_t)NP * 4;
constexpr size_t SZ_WB8 = (size_t)3 * DM * WBP * 2;
constexpr size_t WS_END = WS_WB8 + 2 * SZ_WB8;
constexpr float YSC = 8.0f, WSC = 32.0f;
constexpr int X4P = 1088;
constexpr size_t WS_XN4 = WS_SCR;
constexpr size_t WS_W4 = WS_WBR + (size_t)2 * DM * WBP * 2;
constexpr size_t WS_SA4 = WS_CTL + 131072, WS_SB4 = WS_CTL + 262144;
constexpr int VTP = 16512;
constexpr size_t WS_K8 = WS_END;
constexpr size_t WS_VT8 = WS_K8 + 2 * (size_t)M * 1024;
constexpr size_t WS_END2 = WS_VT8 + (size_t)2048 * VTP;
constexpr size_t WS_X1 = WS_WIN + (size_t)14848 * WKP * 2;
static_assert((size_t)M * DM * 2 <= ((size_t)(NP - 14848) + 14336) * WKP * 2, "X1 must fit between the indexer rows of layer 0 and of layer 1");
constexpr size_t WS_MASK2 = WS_END2;
constexpr size_t WS_MK = WS_KVM, WS_VT = WS_KVM + 4 * MiB;

__device__ __forceinline__ unsigned f2bf(float f) { unsigned u = __builtin_bit_cast(unsigned, f); return (u + 0x7fffu + ((u >> 16) & 1u)) >> 16; }
__device__ __forceinline__ unsigned pk2(float lo, float hi) { unsigned r; asm("v_cvt_pk_bf16_f32 %0, %1, %2" : "=v"(r) : "v"(lo), "v"(hi)); return r; }
__device__ __forceinline__ unsigned pk4f8(float a, float b, float c, float d) { unsigned w = 0u; w = __builtin_amdgcn_cvt_pk_fp8_f32(a, b, w, false); w = __builtin_amdgcn_cvt_pk_fp8_f32(c, d, w, true); return w; }
__device__ __forceinline__ unsigned pk8f4(float a, float b, float c, float d, float e, float f, float g, float h) { unsigned w = 0u;
    w = __builtin_amdgcn_cvt_scalef32_pk_fp4_f32(w, a, b, 1.0f, 0); w = __builtin_amdgcn_cvt_scalef32_pk_fp4_f32(w, c, d, 1.0f, 1); w = __builtin_amdgcn_cvt_scalef32_pk_fp4_f32(w, e, f, 1.0f, 2); w = __builtin_amdgcn_cvt_scalef32_pk_fp4_f32(w, g, h, 1.0f, 3); return w; }
__device__ __forceinline__ float bf2f(unsigned short h) { return __builtin_bit_cast(float, (unsigned)h << 16); }
__device__ __forceinline__ float bflo(unsigned w) { return __builtin_bit_cast(float, w << 16); }
__device__ __forceinline__ float bfhi(unsigned w) { return __builtin_bit_cast(float, w & 0xffff0000u); }
__device__ __forceinline__ float relu_i(float x) { const int b = __builtin_bit_cast(int, x); return __builtin_bit_cast(float, b > 0 ? b : 0); }
__device__ __forceinline__ float sigmoidf_(float x) { return __builtin_amdgcn_rcpf(1.0f + __builtin_amdgcn_exp2f(x * -1.4426950408889634f)); }
__device__ __forceinline__ float siluf_(float x) { return x * __builtin_amdgcn_rcpf(1.0f + __builtin_amdgcn_exp2f(x * -1.4426950408889634f)); }

__device__ __forceinline__ int lane_id_v() { int l; asm volatile("v_mbcnt_lo_u32_b32 %0, -1, 0\n\tv_mbcnt_hi_u32_b32 %0, -1, %0" : "=v"(l)); return l; }
__device__ __forceinline__ int lane_id() { return (int)__builtin_amdgcn_mbcnt_hi(~0u, __builtin_amdgcn_mbcnt_lo(~0u, 0u)); }
__device__ __forceinline__ float xor32_max(float v) { return fmaxf(v, __shfl_xor(v, 32)); }
__device__ __forceinline__ float xor32_sum(float v) { return v + __shfl_xor(v, 32); }
__device__ __forceinline__ float xor16f(float v) { return __builtin_bit_cast(float, __builtin_amdgcn_ds_swizzle(__builtin_bit_cast(int, v), 0x401F)); }

namespace pg8 {
constexpr int BM = 256, BK = 64, HALF = 128, HTB = HALF * BK * 2, STAGE_BYTES = 8 * HTB, NXCD = 8, WGM = 8;
__host__ __device__ __forceinline__ int lds_byte(int r, int c) { const int st = (r >> 4) * 2 + (c >> 5), rr = r & 15, cc = c & 31, ob = rr * 64 + cc * 2; return st * 1024 + (ob ^ (((ob >> 9) & 1) << 5)); }
__host__ __device__ __forceinline__ void stage_rc(int b, int& R, int& C) { const int st = b / 1024, sb = b % 1024, swz = sb ^ (((sb >> 9) & 1) << 5); R = (st >> 1) * 16 + swz / 64; C = (st & 1) * 32 + (swz % 64) / 2; }
__host__ __device__ __forceinline__ int perm32(int rho) { const int n = rho >> 4, i = rho & 15; return 8 * (i >> 2) + 4 * n + (i & 3); }

struct Unit { int pm, pn, z, par; };
struct Gemm { const bf16_t* A; const bf16_t* Bt; int K, lda, ldb; size_t azs, bzs, bbs; };

struct Sched {
    int nM, nN, nZ, zinner, G, c, pmap, skew;
    __device__ __forceinline__ bool next(int i, Unit& u) const {
        const int nwg = nM * nN; long L; int zi;
        if (zinner) { zi = i % nZ; L = (long)(i / nZ) * G + c; if (L >= nwg) return false; }
        else { L = (long)i * G + c;
            if (skew && i >= skew) { if (c < 128 || i >= skew + 2) return false; L = (long)skew * G + (i - skew) * 128 + (c - 128); }
            if (L >= (long)nwg * nZ) return false; zi = (int)(L / nwg); L = L % nwg; }
        int wgid = (int)L; { const int q = nwg / NXCD, r = nwg % NXCD, xcd = wgid % NXCD, off = wgid / NXCD; wgid = (xcd < r ? xcd * (q + 1) : r * (q + 1) + (xcd - r) * q) + off; }
        const int nig = WGM * nN, gid = wgid / nig, fm = gid * WGM, gsz = (nM - fm) < WGM ? (nM - fm) : WGM;
        u.pm = fm + ((wgid % nig) % gsz); u.pn = (wgid % nig) / gsz; u.z = zi;
#ifdef ATT_CHECK
        if (pmap == 1) u.pn = i8_tile(u.pn);
#else
        if (pmap == 1) u.pn = i8g_tile(u.pn);
#endif
        else if (pmap == 3) u.pm = vt_tile(u.pm);
        else if (pmap == 2) u.pn = bf_tile(u.pn);
        return true;
    }
};

template <bool I8>
struct EpiInProj { static __device__ __forceinline__ bool keep(const Unit&) { return false; } static constexpr int ID = 1;
    static constexpr bool PERM = true;
    __device__ __forceinline__ void prefetch(const Unit& u, int wid, int lane) const {
        if constexpr (I8) { const float* gp = (wid < 4) ? SA + u.pm * BM + 64 * wid + lane : SB + u.pn * BM + 64 * (wid - 4) + lane;
            __builtin_amdgcn_global_load_lds((const unsigned*)gp, (LAS unsigned*)(scb + u.par * 512 + wid * 64), 4, 0, 0); } }
    bf16_t* PO; float* IDX; bf16_t* IQC; bf16_t* IKC; unsigned char* G8; const float* SA; const float* SB; const LAS unsigned char* lut; LAS float* scb; unsigned char* K8;
    __device__ __forceinline__ void operator()(f32x4 (&acc)[2][2][4][2], const Unit& u, int wr, int wc, int fr, int fq) const {
        const int pn = u.pn;
        const int row0 = u.pm * BM + wr * 64 + fr;
        if constexpr (I8) {
            float sa[2][4]; f32x4 sb[2][2];
            const LAS float* sc = scb + u.par * 512;
#pragma unroll
            for (int ai = 0; ai < 2; ++ai)
#pragma unroll
                for (int m = 0; m < 4; ++m) sa[ai][m] = sc[ai * HALF + wr * 64 + m * 16 + fr];
#pragma unroll
            for (int bj = 0; bj < 2; ++bj) { sb[bj][0] = *(const LAS f32x4*)(sc + 256 + bj * HALF + wc * 32 + 8 * fq); sb[bj][1] = *(const LAS f32x4*)(sc + 256 + bj * HALF + wc * 32 + 8 * fq + 4); }
            if (pn >= 58) {
                const int col0 = (pn - 58) * BM + wc * 32 + 8 * fq;
                unsigned gofs = (unsigned)row0 * 8192u + (unsigned)col0; asm volatile("" : "+v"(gofs));
#pragma unroll
                for (int ai = 0; ai < 2; ++ai)
#pragma unroll
                    for (int m = 0; m < 4; ++m) { unsigned char* rowp = G8 + (gofs + (unsigned)(ai * HALF + m * 16) * 8192u); const float s256 = sa[ai][m] * 256.0f;
                        unsigned q[2][8];
#pragma unroll
                        for (int bj = 0; bj < 2; ++bj)
#pragma unroll
                            for (int n = 0; n < 2; ++n) { i32x4 iv = __builtin_bit_cast(i32x4, acc[ai][bj][m][n]); asm volatile("" : "+v"(iv));
                                const f32x4 fv = __builtin_convertvector(iv, f32x4) * sb[bj][n];
#pragma unroll
                                for (int e = 0; e < 4; ++e) { const float t = __builtin_amdgcn_fmed3f(fmaf(fv[e], s256, 2048.5f), 0.5f, 4095.5f); q[bj][4 * n + e] = lut[(unsigned)t]; } }
#pragma unroll
                        for (int bj = 0; bj < 2; ++bj) *(u32x2*)(rowp + bj * HALF) = (u32x2){q[bj][0] | (q[bj][1] << 8) | (q[bj][2] << 16) | (q[bj][3] << 24), q[bj][4] | (q[bj][5] << 8) | (q[bj][6] << 16) | (q[bj][7] << 24)};
                        if (m & 1) __builtin_amdgcn_sched_barrier(0); }
                return;
            }
#pragma unroll
            for (int ai = 0; ai < 2; ++ai)
#pragma unroll
                for (int bj = 0; bj < 2; ++bj)
#pragma unroll
                    for (int m = 0; m < 4; ++m)
#pragma unroll
                        for (int n = 0; n < 2; ++n) { const i32x4 iv = __builtin_bit_cast(i32x4, acc[ai][bj][m][n]); acc[ai][bj][m][n] = __builtin_convertvector(iv, f32x4) * (sb[bj][n] * sa[ai][m]); }
        }
        if (I8 && pn >= 16 && pn < 32) {
            const int ch0 = 64 * (pn - 16) + 4 * (wc * 4 + fq);
            int row0c = row0; asm volatile("" : "+v"(row0c));
#pragma unroll
            for (int ai = 0; ai < 2; ++ai)
#pragma unroll
                for (int m = 0; m < 4; ++m) { bf16_t* rowp = PO + (size_t)(row0c + ai * HALF + m * 16) * NPO + ch0;
                    const f32x4 cb = acc[ai][0][m][0], cc = acc[ai][0][m][1], ch = acc[ai][1][m][0], cg = acc[ai][1][m][1];
                    const f32x4 bg = (f32x4){cb[0] * siluf_(cg[0]), cb[1] * siluf_(cg[1]), cb[2] * siluf_(cg[2]), cb[3] * siluf_(cg[3])}, uu = cc * ch;
                    *(u32x2*)(rowp + C_CB) = (u32x2){pk2(bg[0], bg[1]), pk2(bg[2], bg[3])};
                    *(u32x2*)(rowp + C_CC) = (u32x2){pk2(uu[0], uu[1]), pk2(uu[2], uu[3])}; }
            return;
        }
        const int act = ((pn >= 12 && pn < 16) || (pn >= 44 && pn < 48) || (pn >= 52 && pn < 56)) ? 1 : 0;
        const int col0 = pn * BM + wc * 32 + 8 * fq;
        int row0n = row0; asm volatile("" : "+v"(row0n));
#pragma unroll
        for (int ai = 0; ai < 2; ++ai)
#pragma unroll
            for (int m = 0; m < 4; ++m) { const int row = row0n + ai * HALF + m * 16; bf16_t* rowp = PO + (size_t)row * NPO + col0;
#pragma unroll
                for (int bj = 0; bj < 2; ++bj) { f32x4 v0 = acc[ai][bj][m][0], v1 = acc[ai][bj][m][1];
                    if (act == 1) { v0 = (f32x4){siluf_(v0[0]), siluf_(v0[1]), siluf_(v0[2]), siluf_(v0[3])}; v1 = (f32x4){siluf_(v1[0]), siluf_(v1[1]), siluf_(v1[2]), siluf_(v1[3])}; }
                    if (I8 && ((pn >= 4 && pn < 8) || (pn >= 36 && pn < 40))) {
                        const int md = (pn >= 36) ? 1 : 0, kc = (pn - (md ? 36 : 4)) * BM + wc * 32 + 8 * fq + bj * HALF;
                        *(u32x2*)(K8 + ((size_t)md * M + row) * 1024 + kc) = (u32x2){pk4f8(v0[0], v0[1], v0[2], v0[3]), pk4f8(v1[0], v1[1], v1[2], v1[3])};
#ifndef ATT_CHECK
                        continue;
#endif
                    }
                    if (I8 && ((pn >= 12 && pn < 16) || (pn >= 44 && pn < 48))) {
                        const int gb = (pn >= 44) ? 44 : 12;
                        *(u32x2*)((unsigned char*)(PO + (size_t)row * NPO + gb * BM) + (pn - gb) * BM + wc * 32 + 8 * fq + bj * HALF) = (u32x2){pk4f8(v0[0], v0[1], v0[2], v0[3]), pk4f8(v1[0], v1[1], v1[2], v1[3])};
#ifndef ATT_CHECK
                        continue;
#endif
                    }
                    u32x4 w; w.x = pk2(v0[0], v0[1]); w.y = pk2(v0[2], v0[3]); w.z = pk2(v1[0], v1[1]); w.w = pk2(v1[2], v1[3]);
                    *(u32x4*)(rowp + bj * HALF) = w;
                    if (pn == 56 || pn == 57) { const int ic = wc * 32 + 8 * fq + bj * HALF;
                        if (pn == 56) *(u32x4*)(IQC + (size_t)row * 256 + ic) = w; else if (ic < 64) *(u32x4*)(IKC + (size_t)row * 64 + ic) = w; else if (ic == 64) *(f32x4*)(IDX + (size_t)row * 4) = v0; }
                } }
    }
};
struct EpiGate4 { static __device__ __forceinline__ bool keep(const Unit&) { return false; } static constexpr int ID = 9;
    static constexpr bool PERM = true;
    unsigned char* G8; const float* SA4; const float* SB4; const LAS unsigned char* lut; LAS float* scb;
    __device__ __forceinline__ void prefetch(const Unit& u, int wid, int lane) const {
        const float* gp = (wid < 4) ? SA4 + u.pm * BM + 64 * wid + lane : SB4 + u.pn * BM + 64 * (wid - 4) + lane;
        __builtin_amdgcn_global_load_lds((const unsigned*)gp, (LAS unsigned*)(scb + u.par * 512 + wid * 64), 4, 0, 0); }
    __device__ __forceinline__ void operator()(f32x4 (&acc)[2][2][4][2], const Unit& u, int wr, int wc, int fr, int fq) const {
        float sa[2][4]; f32x4 sb[2][2];
        const LAS float* sc = scb + u.par * 512;
#pragma unroll
        for (int ai = 0; ai < 2; ++ai)
#pragma unroll
            for (int m = 0; m < 4; ++m) sa[ai][m] = sc[ai * HALF + wr * 64 + m * 16 + fr];
#pragma unroll
        for (int bj = 0; bj < 2; ++bj) { sb[bj][0] = *(const LAS f32x4*)(sc + 256 + bj * HALF + wc * 32 + 8 * fq); sb[bj][1] = *(const LAS f32x4*)(sc + 256 + bj * HALF + wc * 32 + 8 * fq + 4); }
        const int col0 = (f4_tile(u.pn) - 58) * BM + wc * 32 + 8 * fq;
        unsigned gofs = (unsigned)(u.pm * BM + wr * 64 + fr) * 8192u + (unsigned)col0; asm volatile("" : "+v"(gofs));
#pragma unroll
        for (int ai = 0; ai < 2; ++ai)
#pragma unroll
            for (int m = 0; m < 4; ++m) { unsigned char* rowp = G8 + (gofs + (unsigned)(ai * HALF + m * 16) * 8192u); const float s256 = sa[ai][m] * 256.0f;
                unsigned q[2][8];
#pragma unroll
                for (int bj = 0; bj < 2; ++bj)
#pragma unroll
                    for (int n = 0; n < 2; ++n) { const f32x4 fv = acc[ai][bj][m][n] * sb[bj][n];
#pragma unroll
                        for (int e = 0; e < 4; ++e) { const float t = __builtin_amdgcn_fmed3f(fmaf(fv[e], s256, 2048.5f), 0.5f, 4095.5f); q[bj][4 * n + e] = lut[(unsigned)t]; } }
#pragma unroll
                for (int bj = 0; bj < 2; ++bj) *(u32x2*)(rowp + bj * HALF) = (u32x2){q[bj][0] | (q[bj][1] << 8) | (q[bj][2] << 16) | (q[bj][3] << 24), q[bj][4] | (q[bj][5] << 8) | (q[bj][6] << 16) | (q[bj][7] << 24)};
                if (m & 1) __builtin_amdgcn_sched_barrier(0); }
    }
};
struct EpiVT { static __device__ __forceinline__ bool keep(const Unit&) { return false; } static constexpr int ID = 8;
    static constexpr bool PERM = true;
    unsigned char* VT; const float* rowsc; const float* colsc; LAS float* scb;
    __device__ __forceinline__ void prefetch(const Unit& u, int wid, int lane) const {
        const float* gp = (wid < 4) ? rowsc + u.pm * BM + 64 * wid + lane : colsc + u.pn * BM + 64 * (wid - 4) + lane;
        __builtin_amdgcn_global_load_lds((const unsigned*)gp, (LAS unsigned*)(scb + u.par * 512 + wid * 64), 4, 0, 0); }
    __device__ __forceinline__ void operator()(f32x4 (&acc)[2][2][4][2], const Unit& u, int wr, int wc, int fr, int fq) const {
        float sa[2][4]; f32x4 sb[2][2];
        const LAS float* sc = scb + u.par * 512;
#pragma unroll
        for (int ai = 0; ai < 2; ++ai)
#pragma unroll
            for (int m = 0; m < 4; ++m) sa[ai][m] = sc[ai * HALF + wr * 64 + m * 16 + fr];
#pragma unroll
        for (int bj = 0; bj < 2; ++bj) { sb[bj][0] = *(const LAS f32x4*)(sc + 256 + bj * HALF + wc * 32 + 8 * fq); sb[bj][1] = *(const LAS f32x4*)(sc + 256 + bj * HALF + wc * 32 + 8 * fq + 4); }
        const int md = (u.pm >= 40) ? 1 : 0, vrow0 = md * 1024 + (u.pm - (md ? 40 : 8)) * BM + wr * 64 + fr, tok0 = u.pn * BM + wc * 32 + 8 * fq;
#pragma unroll
        for (int ai = 0; ai < 2; ++ai)
#pragma unroll
            for (int m = 0; m < 4; ++m) { unsigned char* rowp = VT + (size_t)(vrow0 + ai * HALF + m * 16) * VTP + tok0;
#pragma unroll
                for (int bj = 0; bj < 2; ++bj) { const f32x4 v0 = __builtin_convertvector(__builtin_bit_cast(i32x4, acc[ai][bj][m][0]), f32x4) * (sb[bj][0] * sa[ai][m]), v1 = __builtin_convertvector(__builtin_bit_cast(i32x4, acc[ai][bj][m][1]), f32x4) * (sb[bj][1] * sa[ai][m]);
                    *(u32x2*)(rowp + bj * HALF) = (u32x2){pk4f8(v0[0], v0[1], v0[2], v0[3]), pk4f8(v1[0], v1[1], v1[2], v1[3])}; } }
    }
};
struct EpiBf16 { static __device__ __forceinline__ bool keep(const Unit&) { return false; } static constexpr int ID = 2;
    static constexpr bool PERM = true;
    bf16_t* O; int ldc; size_t zstride;
    __device__ __forceinline__ void operator()(f32x4 (&acc)[2][2][4][2], const Unit& u, int wr, int wc, int fr, int fq) const {
        const int row0 = u.pm * BM + wr * 64 + fr, col0 = u.pn * BM + wc * 32 + 8 * fq; bf16_t* base = O + (size_t)u.z * zstride;
#pragma unroll
        for (int ai = 0; ai < 2; ++ai)
#pragma unroll
            for (int m = 0; m < 4; ++m) { bf16_t* rowp = base + (size_t)(row0 + ai * HALF + m * 16) * ldc + col0;
#pragma unroll
                for (int bj = 0; bj < 2; ++bj) { const f32x4 v0 = acc[ai][bj][m][0], v1 = acc[ai][bj][m][1];
                    u32x4 w; w.x = pk2(v0[0], v0[1]); w.y = pk2(v0[2], v0[3]); w.z = pk2(v1[0], v1[1]); w.w = pk2(v1[2], v1[3]);
                    *(u32x4*)(rowp + bj * HALF) = w; } }
    }
};
__device__ __forceinline__ void unpack8(const u32x2 g, float (&f)[8]) {
    f[0] = (float)(g.x & 0xffu); f[1] = (float)((g.x >> 8) & 0xffu); f[2] = (float)((g.x >> 16) & 0xffu); f[3] = (float)(g.x >> 24);
    f[4] = (float)(g.y & 0xffu); f[5] = (float)((g.y >> 8) & 0xffu); f[6] = (float)((g.y >> 16) & 0xffu); f[7] = (float)(g.y >> 24); }
struct EpiMergeC { static constexpr int ID = 7; static constexpr bool PERM = true;
    bf16_t* PO; const unsigned char* G8;
    static __device__ __forceinline__ bool keep(const Unit&) { return false; }
    __device__ __forceinline__ void operator()(f32x4 (&acc)[2][2][4][2], const Unit& u, int wr, int wc, int fr, int fq) const {
        const int row0 = u.pm * BM + wr * 64 + fr, col0 = u.pn * BM + wc * 32 + 8 * fq;
        u32x2 ga[2][4][2];
#pragma unroll
        for (int ai = 0; ai < 2; ++ai)
#pragma unroll
            for (int m = 0; m < 4; ++m) { const unsigned char* grow = G8 + (size_t)(row0 + ai * HALF + m * 16) * 8192 + 2048 + col0;
#pragma unroll
                for (int bj = 0; bj < 2; ++bj) ga[ai][m][bj] = *(const u32x2*)(grow + bj * HALF); }
#pragma unroll
        for (int ai = 0; ai < 2; ++ai)
#pragma unroll
            for (int m = 0; m < 4; ++m) { const size_t row = (size_t)(row0 + ai * HALF + m * 16);
#pragma unroll
                for (int bj = 0; bj < 2; ++bj) { const int c = col0 + bj * HALF;
                    float f[8]; unpack8(ga[ai][m][bj], f);
                    const f32x4 v0 = acc[ai][bj][m][0] * (1.0f / 255.0f), v1 = acc[ai][bj][m][1] * (1.0f / 255.0f);
                    u32x4 w; w.x = pk2(v0[0] * f[0], v0[1] * f[1]); w.y = pk2(v0[2] * f[2], v0[3] * f[3]); w.z = pk2(v1[0] * f[4], v1[1] * f[5]); w.w = pk2(v1[2] * f[6], v1[3] * f[7]);
                    *(u32x4*)(PO + row * NPO + 4096 + c) = w; } }
    }
};
struct EpiMerge { static constexpr int ID = 3; static constexpr bool PERM = true;
    bf16_t* PO; const unsigned char* G8;
    static __device__ __forceinline__ bool keep(const Unit& u) { return u.z < 2; }
    __device__ __forceinline__ void operator()(f32x4 (&acc)[2][2][4][2], const Unit& u, int wr, int wc, int fr, int fq) const {
        const int row0 = u.pm * BM + wr * 64 + fr, col0 = u.pn * BM + wc * 32 + 8 * fq; const int z = u.z;
        if (z < 2) {
            const int oa = (z == 0 ? 0 : 2) * 2048, ob = (z == 0 ? 2 : 3) * 2048;
            u32x2 ga[2][4][2], gb[2][4][2];
#pragma unroll
            for (int ai = 0; ai < 2; ++ai)
#pragma unroll
                for (int m = 0; m < 4; ++m) { const unsigned char* grow = G8 + (size_t)(row0 + ai * HALF + m * 16) * 8192 + col0;
#pragma unroll
                    for (int bj = 0; bj < 2; ++bj) { ga[ai][m][bj] = *(const u32x2*)(grow + oa + bj * HALF); gb[ai][m][bj] = *(const u32x2*)(grow + ob + bj * HALF); } }
#pragma unroll
            for (int ai = 0; ai < 2; ++ai)
#pragma unroll
                for (int m = 0; m < 4; ++m)
#pragma unroll
                    for (int bj = 0; bj < 2; ++bj) { float f[8], h[8]; unpack8(ga[ai][m][bj], f); unpack8(gb[ai][m][bj], h);
#pragma unroll
                        for (int i = 0; i < 8; ++i) f[i] = fmaxf(f[i], 1e-30f) * __builtin_amdgcn_rcpf(fmaxf(h[i], 1e-30f));
                        const f32x4 v0 = acc[ai][bj][m][0], v1 = acc[ai][bj][m][1];
                        acc[ai][bj][m][0] = (f32x4){v0[0] * f[0], v0[1] * f[1], v0[2] * f[2], v0[3] * f[3]}; acc[ai][bj][m][1] = (f32x4){v1[0] * f[4], v1[1] * f[5], v1[2] * f[6], v1[3] * f[7]}; }
        } else {
            constexpr float S = 1.0f / (255.0f * YSC * WSC);
#pragma unroll
            for (int ai = 0; ai < 2; ++ai) {
                u32x2 ga[4][2]; u32x4 pp[4][2];
#pragma unroll
                for (int m = 0; m < 4; ++m) { const size_t row = (size_t)(row0 + ai * HALF + m * 16);
#pragma unroll
                    for (int bj = 0; bj < 2; ++bj) { ga[m][bj] = *(const u32x2*)(G8 + row * 8192 + 3 * 2048 + col0 + bj * HALF); pp[m][bj] = *(const u32x4*)(PO + row * NPO + 4096 + col0 + bj * HALF); } }
                asm volatile("" ::: "memory");
#pragma unroll
                for (int m = 0; m < 4; ++m) { const size_t row = (size_t)(row0 + ai * HALF + m * 16);
#pragma unroll
                    for (int bj = 0; bj < 2; ++bj) { float f[8]; unpack8(ga[m][bj], f); const u32x4 p = pp[m][bj];
                        const f32x4 v0 = acc[ai][bj][m][0] * S, v1 = acc[ai][bj][m][1] * S;
                        u32x4 w; w.x = pk2(fmaf(v0[0], f[0], bflo(p.x)), fmaf(v0[1], f[1], bfhi(p.x))); w.y = pk2(fmaf(v0[2], f[2], bflo(p.y)), fmaf(v0[3], f[3], bfhi(p.y)));
                        w.z = pk2(fmaf(v1[0], f[4], bflo(p.z)), fmaf(v1[1], f[5], bfhi(p.z))); w.w = pk2(fmaf(v1[2], f[6], bflo(p.w)), fmaf(v1[3], f[7], bfhi(p.w)));
                        *(u32x4*)(PO + row * NPO + 4096 + col0 + bj * HALF) = w; } }
                asm volatile("" ::: "memory");
            }
        }
    }
};
template <int MODE>
struct EpiOut { static __device__ __forceinline__ bool keep(const Unit&) { return false; } static constexpr int ID = 4;
    static constexpr bool PERM = true;
    const float* resid; bf16_t* X1;
    __device__ __forceinline__ void operator()(f32x4 (&acc)[2][2][4][2], const Unit& u, int wr, int wc, int fr, int fq) const {
        const int row0 = u.pm * BM + wr * 64 + fr, col0 = u.pn * BM + wc * 32 + 8 * fq;
#pragma unroll
        for (int ai = 0; ai < 2; ++ai) {
            f32x4 r[4][2][2];
#pragma unroll
            for (int m = 0; m < 4; ++m) {
#pragma unroll
                for (int bj = 0; bj < 2; ++bj) {
                    if constexpr (MODE == 1) { const float* rp = resid + (size_t)(row0 + ai * HALF + m * 16) * DM + col0 + bj * HALF; r[m][bj][0] = *(const f32x4*)rp; r[m][bj][1] = *(const f32x4*)(rp + 4); }
                    else { const u32x4 w = *(const u32x4*)(X1 + (size_t)(row0 + ai * HALF + m * 16) * DM + col0 + bj * HALF); r[m][bj][0] = (f32x4){bflo(w.x), bfhi(w.x), bflo(w.y), bfhi(w.y)}; r[m][bj][1] = (f32x4){bflo(w.z), bfhi(w.z), bflo(w.w), bfhi(w.w)}; } } }
            asm volatile("" ::: "memory");
#pragma unroll
            for (int m = 0; m < 4; ++m) { bf16_t* op = X1 + (size_t)(row0 + ai * HALF + m * 16) * DM + col0;
#pragma unroll
                for (int bj = 0; bj < 2; ++bj) { const f32x4 v0 = acc[ai][bj][m][0] + r[m][bj][0], v1 = acc[ai][bj][m][1] + r[m][bj][1];
                    *(u32x4*)(op + bj * HALF) = (u32x4){pk2(v0[0], v0[1]), pk2(v0[2], v0[3]), pk2(v1[0], v1[1]), pk2(v1[2], v1[3])}; } }
            asm volatile("" ::: "memory");
        }
    }
};

struct EpiSoftmax { static __device__ __forceinline__ bool keep(const Unit&) { return false; } static constexpr int ID = 5;
    static constexpr bool PERM = true;
    bf16_t* PM; LAS float* xl;
    __device__ __forceinline__ void operator()(f32x4 (&acc)[2][2][4][2], const Unit& u, int wr, int wc, int fr, int fq) const {
        constexpr float C = 0.0625f * 1.4426950408889634f;
        int rb_ = (wr * 64 + fr) * 4; asm volatile("" : "+v"(rb_));
        LAS float* Pm = xl + rb_; LAS float* Ps = xl + 1024 + rb_;
#pragma unroll
        for (int ai = 0; ai < 2; ++ai)
#pragma unroll
            for (int m = 0; m < 4; ++m) { float mx = -INFINITY;
#pragma unroll
                for (int bj = 0; bj < 2; ++bj)
#pragma unroll
                    for (int n = 0; n < 2; ++n) { const f32x4 x = acc[ai][bj][m][n]; mx = fmaxf(mx, fmaxf(fmaxf(x[0], x[1]), fmaxf(x[2], x[3]))); }
                mx = fmaxf(mx, xor16f(mx)); mx = xor32_max(mx);
                if (fq == 0) Pm[(ai * HALF + m * 16) * 4 + wc] = mx; }
        asm volatile("s_waitcnt lgkmcnt(0)" ::: "memory"); __builtin_amdgcn_s_barrier(); asm volatile("" ::: "memory");
#pragma unroll
        for (int ai = 0; ai < 2; ++ai)
#pragma unroll
            for (int m = 0; m < 4; ++m) { const int row = ai * HALF + m * 16; const f32x4 pm4 = *(const LAS f32x4*)(Pm + row * 4);
                const float mm = fmaxf(fmaxf(pm4[0], pm4[1]), fmaxf(pm4[2], pm4[3])) * C; float sm = 0.f;
#pragma unroll
                for (int bj = 0; bj < 2; ++bj)
#pragma unroll
                    for (int n = 0; n < 2; ++n) { f32x4 x = acc[ai][bj][m][n];
                        x = (f32x4){__builtin_amdgcn_exp2f(fmaf(x[0], C, -mm)), __builtin_amdgcn_exp2f(fmaf(x[1], C, -mm)), __builtin_amdgcn_exp2f(fmaf(x[2], C, -mm)), __builtin_amdgcn_exp2f(fmaf(x[3], C, -mm))};
                        acc[ai][bj][m][n] = x; sm += (x[0] + x[1]) + (x[2] + x[3]); }
                sm += xor16f(sm); sm = xor32_sum(sm);
                if (fq == 0) Ps[row * 4 + wc] = sm; }
        asm volatile("s_waitcnt lgkmcnt(0)" ::: "memory"); __builtin_amdgcn_s_barrier(); asm volatile("" ::: "memory");
        const int row0 = u.pm * BM + wr * 64 + fr, col0 = u.z * 256 + wc * 32 + 8 * fq;
#pragma unroll
        for (int ai = 0; ai < 2; ++ai)
#pragma unroll
            for (int m = 0; m < 4; ++m) { const int row = ai * HALF + m * 16; const f32x4 ps4 = *(const LAS f32x4*)(Ps + row * 4);
                const float inv = 1.0f / ((ps4[0] + ps4[1]) + (ps4[2] + ps4[3])); bf16_t* rowp = PM + (size_t)(row0 + ai * HALF + m * 16) * 1024 + col0;
#pragma unroll
                for (int bj = 0; bj < 2; ++bj) { const f32x4 v0 = acc[ai][bj][m][0] * inv, v1 = acc[ai][bj][m][1] * inv;
                    u32x4 w; w.x = pk2(v0[0], v0[1]); w.y = pk2(v0[2], v0[3]); w.z = pk2(v1[0], v1[1]); w.w = pk2(v1[2], v1[3]);
                    *(u32x4*)(rowp + bj * HALF) = w; } }
        asm volatile("s_waitcnt lgkmcnt(0)" ::: "memory"); __builtin_amdgcn_s_barrier(); asm volatile("" ::: "memory");
    }
};
struct EpiMemOut { static __device__ __forceinline__ bool keep(const Unit&) { return false; } static constexpr int ID = 6;
    static constexpr bool PERM = true;
    const bf16_t* PO; unsigned char* Y;
    __device__ __forceinline__ void operator()(f32x4 (&acc)[2][2][4][2], const Unit& u, int wr, int wc, int fr, int fq) const {
        const int row0 = u.pm * BM + wr * 64 + fr, col0 = u.z * 256 + wc * 32 + 8 * fq;
        u32x4 gg[2][4][2];
#pragma unroll
        for (int ai = 0; ai < 2; ++ai)
#pragma unroll
            for (int m = 0; m < 4; ++m)
#pragma unroll
                for (int bj = 0; bj < 2; ++bj) gg[ai][m][bj] = *(const u32x4*)(PO + (size_t)(row0 + ai * HALF + m * 16) * NPO + C_MG + col0 + bj * HALF);
        asm volatile("" ::: "memory");
#pragma unroll
        for (int ai = 0; ai < 2; ++ai)
#pragma unroll
            for (int m = 0; m < 4; ++m) { const size_t row = (size_t)(row0 + ai * HALF + m * 16);
#pragma unroll
                for (int bj = 0; bj < 2; ++bj) { const int c = col0 + bj * HALF; const u32x4 g = gg[ai][m][bj];
                    const f32x4 s0 = acc[ai][bj][m][0] * YSC, s1 = acc[ai][bj][m][1] * YSC;
                    *(u32x2*)(Y + row * YB + 2048 + c) = (u32x2){pk4f8(s0[0] * bflo(g.x), s0[1] * bfhi(g.x), s0[2] * bflo(g.y), s0[3] * bfhi(g.y)), pk4f8(s1[0] * bflo(g.z), s1[1] * bfhi(g.z), s1[2] * bflo(g.w), s1[3] * bfhi(g.w))}; } }
    }
};

template <class Epi, bool ALIGN_EPI, int KIND = 0>
__device__ __forceinline__ void gemm_phase(LAS unsigned char* lds, const Gemm g, const Sched& S, const Epi& E, int wave_s, bool noepi = false) {
    int tid_ = wave_s * 64 + lane_id_v(); asm volatile("" : "+v"(tid_));
    const int tid = tid_, wid = __builtin_amdgcn_readfirstlane(tid >> 6), lane = tid & 63, wr = wid >> 2, wc = wid & 3, fr = lane & 15, fq = lane >> 4;
    const int K = g.K;
    unsigned voffA[2], voffB[2];
#pragma unroll
    for (int i = 0; i < 2; ++i) { int R, C; stage_rc(tid * 16 + i * 8192, R, C); const int Rb = Epi::PERM ? ((R & ~31) + perm32(R & 31)) : R;
        voffA[i] = (unsigned)(R * g.lda + C) * 2u; voffB[i] = (unsigned)(Rb * g.ldb + C) * 2u; }
    const size_t kstep = (size_t)(BK * 2);
    const size_t hsA = (size_t)HALF * g.lda * 2, hsB = (size_t)HALF * g.ldb * 2;
    const size_t tsA = 2 * hsA, tsB = 2 * hsB;
    const unsigned ldsw = (unsigned)wid * 1024u;
    const int aoff = lds_byte(wr * 64 + fr, fq * 8), boff = lds_byte(wc * 32 + fr, fq * 8);
#define PG8_SA(b, h) (((b) * 2 + (h)) * HTB)
#define PG8_SB(b, h) ((4 + (b) * 2 + (h)) * HTB)
#define PG8_STAGE(bufoff, gbase, voff) do { _Pragma("unroll") for (int _i = 0; _i < 2; ++_i) \
        __builtin_amdgcn_global_load_lds((const unsigned*)((const char*)(gbase) + (voff)[_i]), (LAS unsigned*)(lds + (bufoff) + ldsw + _i * 8192), 16, 0, 0); } while (0)
#define PG8_LDA(dst, b, h) do { _Pragma("unroll") for (int m = 0; m < 4; ++m) _Pragma("unroll") for (int k = 0; k < 2; ++k) dst[m][k] = *(const LAS bf16x8*)(lds + PG8_SA(b, h) + aoff + m * 2048 + k * 1024); } while (0)
#define PG8_LDB(dst, b, h) do { _Pragma("unroll") for (int n = 0; n < 2; ++n) _Pragma("unroll") for (int k = 0; k < 2; ++k) dst[n][k] = *(const LAS bf16x8*)(lds + PG8_SB(b, h) + boff + n * 2048 + k * 1024); } while (0)
#define PG8_MMA(TY, ai, bj, At, Bt) do { __builtin_amdgcn_s_setprio(1); _Pragma("unroll") for (int m = 0; m < 4; ++m) _Pragma("unroll") for (int n = 0; n < 2; ++n) { \
        if constexpr ((TY) == 2) { const i32x8 b8_ = __builtin_shufflevector(__builtin_bit_cast(i32x4, Bt[n][0]), __builtin_bit_cast(i32x4, Bt[n][1]), 0, 1, 2, 3, 4, 5, 6, 7), a8_ = __builtin_shufflevector(__builtin_bit_cast(i32x4, At[m][0]), __builtin_bit_cast(i32x4, At[m][1]), 0, 1, 2, 3, 4, 5, 6, 7); \
            asm volatile("v_mfma_f32_16x16x128_f8f6f4 %0, %1, %2, %0" : "+v"(acc[ai][bj][m][n]) : "v"(b8_), "v"(a8_)); }   \
        else if constexpr ((TY) == 3) { _Pragma("unroll") for (int k = 0; k < 2; ++k) { const i32x4 b4_ = __builtin_bit_cast(i32x4, Bt[n][k]), a4_ = __builtin_bit_cast(i32x4, At[m][k]); \
            asm volatile("v_mfma_f32_16x16x128_f8f6f4 %0, %1, %2, %0 cbsz:4 blgp:4" : "+v"(acc[ai][bj][m][n]) : "v"(b4_), "v"(a4_)); } } \
        else { _Pragma("unroll") for (int k = 0; k < 2; ++k) { \
            if constexpr ((TY) == 1) acc[ai][bj][m][n] = __builtin_bit_cast(f32x4, __builtin_amdgcn_mfma_i32_16x16x64_i8(__builtin_bit_cast(i32x4, Bt[n][k]), __builtin_bit_cast(i32x4, At[m][k]), __builtin_bit_cast(i32x4, acc[ai][bj][m][n]), 0, 0, 0)); \
            else acc[ai][bj][m][n] = __builtin_amdgcn_mfma_f32_16x16x32_bf16(Bt[n][k], At[m][k], acc[ai][bj][m][n], 0, 0, 0); } } } __builtin_amdgcn_s_setprio(0); } while (0)
#define PG8_WAIT_V(n) asm volatile("s_waitcnt vmcnt(" #n ")" ::: "memory")
#define PG8_WAIT_L(n) asm volatile("s_waitcnt lgkmcnt(" #n ")" ::: "memory")
#define PG8_BAR __builtin_amdgcn_s_barrier()
#define PG8_SCHED __builtin_amdgcn_sched_barrier(0)
#define PG8_WAIT_VR(nr) do { if (rlx) asm volatile("s_waitcnt vmcnt(" #nr ")" ::: "memory"); else asm volatile("s_waitcnt vmcnt(8)" ::: "memory"); } while (0)
#define PG8_KLOOP(TY) _Pragma("unroll 1") for (int t = 0; t < nt; t += 2) { \
            const bool last = (t == nt - 2), rlx = (t == 0) && (ui > 0); \
            const char* a1 = cA + (size_t)(t + 1) * kstep; \
            const char* a2 = last ? nA : cA + (size_t)(t + 2) * kstep; const char* b2 = last ? nB : cB + (size_t)(t + 2) * kstep; \
            const char* a3 = a2 + kstep; const char* b3 = b2 + kstep; \
            PG8_LDB(B0, 0, 0); PG8_LDB(B1, 0, 1); PG8_SCHED; PG8_LDA(At, 0, 0); PG8_STAGE(PG8_SA(1, 1), a1 + hsA, voffA); \
            PG8_WAIT_VR(26); PG8_WAIT_L(0); PG8_BAR; PG8_MMA(TY, 0, 0, At, B0); PG8_MMA(TY, 0, 1, At, B1); PG8_BAR; PG8_SCHED; \
            PG8_LDA(At, 0, 1); PG8_STAGE(PG8_SB(0, 0), b2, voffB); PG8_STAGE(PG8_SB(0, 1), b2 + hsB, voffB); PG8_STAGE(PG8_SA(0, 0), a2, voffA); \
            PG8_WAIT_VR(30); PG8_WAIT_L(0); PG8_BAR; PG8_MMA(TY, 1, 0, At, B0); PG8_MMA(TY, 1, 1, At, B1); PG8_BAR; PG8_SCHED; \
            PG8_LDB(B0, 1, 0); PG8_LDB(B1, 1, 1); PG8_SCHED; PG8_LDA(At, 1, 0); PG8_STAGE(PG8_SA(0, 1), a2 + hsA, voffA); \
            PG8_WAIT_VR(26); PG8_WAIT_L(0); PG8_BAR; PG8_MMA(TY, 0, 0, At, B0); PG8_MMA(TY, 0, 1, At, B1); PG8_BAR; PG8_SCHED; \
            PG8_LDA(At, 1, 1); PG8_STAGE(PG8_SB(1, 0), b3, voffB); PG8_STAGE(PG8_SB(1, 1), b3 + hsB, voffB); PG8_STAGE(PG8_SA(1, 0), a3, voffA); \
            PG8_WAIT_VR(14); PG8_WAIT_L(0); PG8_BAR; PG8_MMA(TY, 1, 0, At, B0); PG8_MMA(TY, 1, 1, At, B1); PG8_BAR; PG8_SCHED; \
        }
    Unit cur, nxt; int ui = 0;
    if (!S.next(0, cur)) return;
    f32x4 acc[2][2][4][2];
#pragma unroll
    for (int a = 0; a < 2; ++a)
#pragma unroll
        for (int b = 0; b < 2; ++b)
#pragma unroll
            for (int m = 0; m < 4; ++m)
#pragma unroll
                for (int n = 0; n < 2; ++n) acc[a][b][m][n] = (f32x4){0.f, 0.f, 0.f, 0.f};
    bf16x8 At[4][2], B0[2][2], B1[2][2];
    const char* cA = (const char*)g.A + (size_t)cur.pm * tsA + (size_t)cur.z * g.azs; const char* cB = (const char*)g.Bt + (size_t)cur.pn * tsB + (size_t)cur.z * g.bzs + (size_t)(cur.pm >> 4) * g.bbs;
    PG8_STAGE(PG8_SB(0, 0), cB, voffB); PG8_STAGE(PG8_SB(0, 1), cB + hsB, voffB); PG8_STAGE(PG8_SA(0, 0), cA, voffA); PG8_STAGE(PG8_SA(0, 1), cA + hsA, voffA);
    if (wr == 1) PG8_BAR;
    PG8_WAIT_V(2); PG8_BAR;
    PG8_STAGE(PG8_SB(1, 0), cB + kstep, voffB); PG8_STAGE(PG8_SA(1, 0), cA + kstep, voffA); PG8_STAGE(PG8_SB(1, 1), cB + hsB + kstep, voffB);
    PG8_WAIT_V(6); PG8_BAR;
    for (;;) {
        cur.par = ui & 1;
        if constexpr (KIND == 1 || KIND == 3) E.prefetch(cur, wid, lane_id_v());
        const bool has_next = S.next(ui + 1, nxt);
        const char* nA = has_next ? (const char*)g.A + (size_t)nxt.pm * tsA + (size_t)nxt.z * g.azs : cA;
        const char* nB = has_next ? (const char*)g.Bt + (size_t)nxt.pn * tsB + (size_t)nxt.z * g.bzs + (size_t)(nxt.pm >> 4) * g.bbs : cB;
        const int nt = K / BK;
        PG8_KLOOP(KIND)
        if constexpr (KIND == 2 || KIND == 3) asm volatile("s_nop 15\n\ts_nop 7" ::: "memory");
        if constexpr (ALIGN_EPI) { if (wr == 0) PG8_BAR; }
        if (!noepi) { const int l2 = lane_id_v(); E(acc, cur, wr, wc, l2 & 15, l2 >> 4); }
        if (!has_next) break;
        if (!Epi::keep(cur)) {
#pragma unroll
        for (int a = 0; a < 2; ++a)
#pragma unroll
            for (int b = 0; b < 2; ++b)
#pragma unroll
                for (int m = 0; m < 4; ++m)
#pragma unroll
                    for (int n = 0; n < 2; ++n) acc[a][b][m][n] = (f32x4){0.f, 0.f, 0.f, 0.f};
        }
        cur = nxt; cA = nA; cB = nB; ++ui;
        if constexpr (ALIGN_EPI) { if (wr == 1) PG8_BAR; }
    }
    PG8_WAIT_V(0);
    if constexpr (!ALIGN_EPI) { if (wr == 0) PG8_BAR; }
    PG8_BAR;
#undef PG8_SA
#undef PG8_SB
#undef PG8_STAGE
#undef PG8_LDA
#undef PG8_LDB
#undef PG8_MMA
#undef PG8_KLOOP
#undef PG8_WAIT_VR
#undef PG8_WAIT_V
#undef PG8_WAIT_L
#undef PG8_BAR
#undef PG8_SCHED
}
}


namespace att {
using s16x4  = __attribute__((ext_vector_type(4))) short;
using f32x16 = __attribute__((ext_vector_type(16))) float;
constexpr int D = 128, NW = 8, QBLK = 32, KVBLK = 64;
constexpr float SCALE = 0.088388347648318440f, THR = 8.f;
constexpr int SHM_V = KVBLK * D * 2, SHM_K = KVBLK * D * 2, SHM_ATTN = 2 * SHM_V + 2 * SHM_K + NW * 64 * 4, KM_OFF = SHM_ATTN, KM_BYTES = 16 * 128 * 4, ATT_LDS = KM_OFF + KM_BYTES;
#define KSWZ(row, colB) ((row) * 256 + ((colB) ^ (((row) & 7) << 4)))
#define SBAR() __builtin_amdgcn_sched_barrier(0)
__device__ __forceinline__ int crow(int r, int hi) { return (r & 3) + 8 * (r >> 2) + 4 * hi; }
__device__ __forceinline__ unsigned cvtpk(float lo, float hi) { unsigned r; asm volatile("v_cvt_pk_bf16_f32 %0, %1, %2" : "=v"(r) : "v"(lo), "v"(hi)); return r; }

__device__ __forceinline__ float bfi_f(unsigned m, float x) { return __uint_as_float(__builtin_amdgcn_bitop3_b32(__float_as_uint(x), 0xff800000u, m, 0xe4)); }
struct MaskInfo { unsigned sel; int qrel; int qb; u32x2 w; };
template <int MODE>
__device__ __forceinline__ void apply_mask(f32x16& p0, f32x16& p1, const MaskInfo& mi, int j, int hi) {
    const float NEG = -INFINITY;
    if (MODE == 0) {
        const int blk = j >> 2;
        if (blk == mi.qb) { const int kb = 64 * (j & 3) + 4 * hi;
#pragma unroll
            for (int r = 0; r < 16; ++r) { const int kv = kb + (r & 3) + 8 * (r >> 2); if (kv > mi.qrel) p0[r] = NEG; if (kv + 32 > mi.qrel) p1[r] = NEG; } }
    } else {
        const unsigned w0 = mi.w.x >> (4 * hi), w1 = mi.w.y >> (4 * hi);
#pragma unroll
        for (int r = 0; r < 16; ++r) { const int pos = (r & 3) + 8 * (r >> 2);
            const unsigned m0 = (unsigned)__builtin_amdgcn_sbfe((int)w0, pos, 1), m1 = (unsigned)__builtin_amdgcn_sbfe((int)w1, pos, 1);
            p0[r] = bfi_f(m0, p0[r]); p1[r] = bfi_f(m1, p1[r]); }
        (void)NEG;
    }
}
__device__ __forceinline__ void partialSM(f32x16& p0, f32x16& p1, float& m_reg, float& mn, float& alpha, bool rowon) {
    constexpr float C = SCALE * 1.4426950408889634f;
    float pmax = p0[0];
#pragma unroll
    for (int r = 1; r < 16; ++r) pmax = fmaxf(pmax, p0[r]);
#pragma unroll
    for (int r = 0; r < 16; ++r) pmax = fmaxf(pmax, p1[r]);
    { auto rr = __builtin_amdgcn_permlane32_swap(__float_as_uint(pmax), __float_as_uint(pmax), false, false);
      pmax = fmaxf(__uint_as_float(rr[0]), __uint_as_float(rr[1])); }
    pmax = rowon ? pmax : -INFINITY;
    if (__builtin_expect(__all(pmax - m_reg <= THR / SCALE), 1)) { mn = m_reg; alpha = 1.f; }
    else { mn = fmaxf(m_reg, pmax); alpha = __builtin_amdgcn_exp2f((m_reg - mn) * C); m_reg = mn; }
    const float mnC = rowon ? -mn * C : -INFINITY;
#pragma unroll
    for (int r = 0; r < 16; ++r) p0[r] = fmaf(p0[r], C, mnC);
#pragma unroll
    for (int r = 0; r < 16; ++r) p1[r] = fmaf(p1[r], C, mnC);
#pragma unroll
    for (int r = 0; r < 16; ++r) p0[r] = __builtin_amdgcn_exp2f(p0[r]);
}
__device__ __forceinline__ void finishSM(f32x16& p0, f32x16& p1, float alpha, float& l_reg, bf16x8& pa0, bf16x8& pa1, bf16x8& pa2, bf16x8& pa3) {
#pragma unroll
    for (int r = 0; r < 16; ++r) p1[r] = __builtin_amdgcn_exp2f(p1[r]);
    float ps = 0;
#pragma unroll
    for (int r = 0; r < 16; ++r) ps += p0[r];
#pragma unroll
    for (int r = 0; r < 16; ++r) ps += p1[r];
    { auto rr = __builtin_amdgcn_permlane32_swap(__float_as_uint(ps), __float_as_uint(ps), false, false);
      ps = __uint_as_float(rr[0]) + __uint_as_float(rr[1]); }
    l_reg = l_reg * alpha + ps;
#define PK4(P, BASE, OUT) do { unsigned a0 = cvtpk(P[BASE + 0], P[BASE + 1]), a1 = cvtpk(P[BASE + 2], P[BASE + 3]);   \
    unsigned b0 = cvtpk(P[BASE + 4], P[BASE + 5]), b1 = cvtpk(P[BASE + 6], P[BASE + 7]);                              \
    auto r0 = __builtin_amdgcn_permlane32_swap(a0, b0, false, false); auto r1 = __builtin_amdgcn_permlane32_swap(a1, b1, false, false); \
    u32x4 w = {r0[0], r1[0], r0[1], r1[1]}; OUT = *reinterpret_cast<bf16x8*>(&w); } while (0)
    PK4(p0, 0, pa0); PK4(p0, 8, pa1); PK4(p1, 0, pa2); PK4(p1, 8, pa3);
#undef PK4
}
__device__ __forceinline__ void qkt(f32x16& p0, f32x16& p1, const LAS char* Ks, const bf16x8* qr, int r32, int hi) {
    p0 = f32x16{}; p1 = f32x16{};
#pragma unroll
    for (int d0 = 0; d0 < 8; ++d0) { const int cb = (d0 * 16 + hi * 8) * 2;
        const bf16x8 b0 = *reinterpret_cast<const LAS bf16x8*>(Ks + KSWZ(r32, cb));
        const bf16x8 b1 = *reinterpret_cast<const LAS bf16x8*>(Ks + KSWZ(32 + r32, cb));
        p0 = __builtin_amdgcn_mfma_f32_32x32x16_bf16(b0, qr[d0], p0, 0, 0, 0);
        p1 = __builtin_amdgcn_mfma_f32_32x32x16_bf16(b1, qr[d0], p1, 0, 0, 0); }
}
__device__ __forceinline__ int v_st(int k, int c) { const int kk = (k & ~0xC) | ((k & 4) << 1) | ((k & 8) >> 1); return ((kk >> 3) * 4 + (c >> 5)) * 512 + ((kk & 7) * 32 + (c & 31)) * 2; }
__device__ __forceinline__ int v_rd_base(int lane) { return ((lane & 3) << 3) | (((lane >> 2) & 3) << 6) | (((lane >> 4) & 1) << 5) | (((lane >> 5) & 1) << 8); }
constexpr int v_rd_off(int d0, int ks, int half) { return d0 * 512 + ks * 4096 + half * 2048; }
template <int OFF> __device__ __forceinline__ s16x4 tr_read(int vb) {
    s16x4 r; asm volatile("ds_read_b64_tr_b16 %0, %1 offset:%2" : "=&v"(r) : "v"(vb), "i"(OFF) : "memory"); return r;
}
template <int D0> __device__ __forceinline__ void pv_one(f32x16& od, int vb, bf16x8 pa0, bf16x8 pa1, bf16x8 pa2, bf16x8 pa3) {
    const s16x4 l0 = tr_read<v_rd_off(D0, 0, 0)>(vb), h0 = tr_read<v_rd_off(D0, 0, 1)>(vb), l1 = tr_read<v_rd_off(D0, 1, 0)>(vb), h1 = tr_read<v_rd_off(D0, 1, 1)>(vb);
    const s16x4 l2 = tr_read<v_rd_off(D0, 2, 0)>(vb), h2 = tr_read<v_rd_off(D0, 2, 1)>(vb), l3 = tr_read<v_rd_off(D0, 3, 0)>(vb), h3 = tr_read<v_rd_off(D0, 3, 1)>(vb);
    asm volatile("s_waitcnt lgkmcnt(0)" ::: "memory"); SBAR();
#define PK(L, H) (bf16x8){L[0], L[1], L[2], L[3], H[0], H[1], H[2], H[3]}
    od = __builtin_amdgcn_mfma_f32_32x32x16_bf16(pa0, PK(l0, h0), od, 0, 0, 0);
    od = __builtin_amdgcn_mfma_f32_32x32x16_bf16(pa1, PK(l1, h1), od, 0, 0, 0);
    od = __builtin_amdgcn_mfma_f32_32x32x16_bf16(pa2, PK(l2, h2), od, 0, 0, 0);
    od = __builtin_amdgcn_mfma_f32_32x32x16_bf16(pa3, PK(l3, h3), od, 0, 0, 0);
#undef PK
}
__device__ __forceinline__ void pv_d0(f32x16* o, int vb, bf16x8 pa0, bf16x8 pa1, bf16x8 pa2, bf16x8 pa3) {
    pv_one<0>(o[0], vb, pa0, pa1, pa2, pa3); pv_one<1>(o[1], vb, pa0, pa1, pa2, pa3); pv_one<2>(o[2], vb, pa0, pa1, pa2, pa3); pv_one<3>(o[3], vb, pa0, pa1, pa2, pa3);
}

template <int MODE>
__device__ __forceinline__ void attn_unit(const bf16_t* __restrict__ Qb, const bf16_t* __restrict__ Kh, const bf16_t* __restrict__ Vh, const bf16_t* __restrict__ Gb, unsigned char* __restrict__ Yb,
                                          const float* __restrict__ km, const unsigned* __restrict__ mrow0, int qb, LAS char* lds, int wave_s) {
    int tid_ = wave_s * 64 + lane_id_v(); asm volatile("" : "+v"(tid_));
    const int tid = tid_, wid = tid >> 6, lane = tid & 63, r32 = lane & 31, hi = lane >> 5;
    constexpr long LDQ = NPO, LDK = NPO;
    LAS char* V_lds = lds; LAS char* K_lds = lds + 2 * SHM_V;
    LAS float* wsl = (LAS float*)(lds + 2 * SHM_V + 2 * SHM_K) + wid * 64; LAS float* li_l = wsl; LAS float* al_l = wsl + 32;
    float m_reg = -1e30f, l_reg = 0; f32x16 o[4] = {}; bf16x8 qr[8];
    const bf16_t* Qw = Qb + (long)(wid * QBLK + r32) * LDQ + hi * 8;
#pragma unroll
    for (int d0 = 0; d0 < 8; ++d0) qr[d0] = *reinterpret_cast<const bf16x8*>(Qw + d0 * 16);
    MaskInfo mi; mi.sel = 0u; mi.qrel = wid * QBLK + r32; mi.qb = qb; mi.w = (u32x2){0u, 0u};
    const unsigned* mrow = nullptr;
    if (MODE == 0) {
        LAS float* kms = (LAS float*)(lds + KM_OFF);
        *(LAS f32x4*)(kms + tid * 4) = *(const f32x4*)(km + tid * 4);
        __syncthreads();
        if (qb <= 3) mi.sel = (1u << qb) - 1u;
        else {
            float qf[64];
#pragma unroll
            for (int d0 = 0; d0 < 8; ++d0)
#pragma unroll
                for (int e = 0; e < 8; ++e) qf[d0 * 8 + e] = bf2f((unsigned short)qr[d0][e]);
            float bs[15];
#pragma unroll
            for (int n = 0; n < 15; ++n) { float s = 0.f;
                if (n < qb) {
#pragma unroll
                    for (int d0 = 0; d0 < 8; ++d0) { const f32x4 k0 = *(const LAS f32x4*)(kms + n * 128 + d0 * 16 + hi * 8), k1 = *(const LAS f32x4*)(kms + n * 128 + d0 * 16 + hi * 8 + 4);
                        s += qf[d0 * 8 + 0] * k0.x + qf[d0 * 8 + 1] * k0.y + qf[d0 * 8 + 2] * k0.z + qf[d0 * 8 + 3] * k0.w + qf[d0 * 8 + 4] * k1.x + qf[d0 * 8 + 5] * k1.y + qf[d0 * 8 + 6] * k1.z + qf[d0 * 8 + 7] * k1.w; }
                    s += __shfl_xor(s, 32); }
                bs[n] = s; }
            unsigned chosen = 0u;
#pragma unroll
            for (int rr = 0; rr < 3; ++rr) { float best = 0.f; int bi = -1;
#pragma unroll
                for (int n = 0; n < 15; ++n) { const bool ok = (n < qb) && !((chosen >> n) & 1u) && (bi < 0 || bs[n] > best); best = ok ? bs[n] : best; bi = ok ? n : bi; }
                chosen |= 1u << bi; }
            mi.sel = chosen;
        }
    } else {
        mrow = mrow0 + (size_t)(wid * QBLK + r32) * 128;
    }
    const int sr = tid >> 4, sc = (tid & 15) * 8, vst0 = v_st(sr, sc), vst1 = v_st(32 + sr, sc);
    const int vb0 = (int)(unsigned)(uintptr_t)V_lds + v_rd_base(lane);
    struct { bf16x8 vs0, vs1, ks0, ks1; } sr_[2];
#define SLOAD(i, k0) do { sr_[i].vs0 = *reinterpret_cast<const bf16x8*>(&Vh[(long)((k0) + sr) * LDK + sc]); sr_[i].vs1 = *reinterpret_cast<const bf16x8*>(&Vh[(long)((k0) + 32 + sr) * LDK + sc]); \
    sr_[i].ks0 = *reinterpret_cast<const bf16x8*>(&Kh[(long)((k0) + sr) * LDK + sc]); sr_[i].ks1 = *reinterpret_cast<const bf16x8*>(&Kh[(long)((k0) + 32 + sr) * LDK + sc]); } while (0)
#define SWRITE(b, i) do { *(LAS bf16x8*)(V_lds + (b) * SHM_V + vst0) = sr_[i].vs0;          \
    *(LAS bf16x8*)(V_lds + (b) * SHM_V + vst1) = sr_[i].vs1; const int kc = sc * 2;               \
    *(LAS bf16x8*)(K_lds + (b) * SHM_K + KSWZ(sr, kc)) = sr_[i].ks0;                       \
    *(LAS bf16x8*)(K_lds + (b) * SHM_K + KSWZ(32 + sr, kc)) = sr_[i].ks1; } while (0)
#define SWAIT() asm volatile("s_waitcnt vmcnt(4)" ::: "memory")
#define RESC(a) do { if (__any((a) < 1.f)) { if (hi == 0) al_l[r32] = (a); asm volatile("s_waitcnt lgkmcnt(0)" ::: "memory"); \
    _Pragma("unroll") for (int d = 0; d < 4; ++d) _Pragma("unroll") for (int r = 0; r < 16; ++r) o[d][r] *= al_l[crow(r, hi)]; } } while (0)
#define MLOAD(dst, j) do { if (MODE == 1) dst = *(const u32x2*)(mrow + 2 * (j)); } while (0)
#define ROWON(j) (MODE == 1 || ((j) >> 2) == qb || ((mi.sel >> ((j) >> 2)) & 1u))
    f32x16 pA0, pA1, pB0, pB1; float mnA, mnB, alA, alB; bf16x8 pa0, pa1, pa2, pa3; const int NT = 4 * (qb + 1);
    u32x2 mA = (u32x2){0u, 0u}, mB = (u32x2){0u, 0u};
    constexpr int SE = 0, SO = 1;
    MLOAD(mA, 0); MLOAD(mB, 1);
    SLOAD(SE, 0); asm volatile("s_waitcnt vmcnt(0)" ::: "memory"); SWRITE(0, SE); __syncthreads();
    qkt(pA0, pA1, K_lds, qr, r32, hi); mi.w = mA; apply_mask<MODE>(pA0, pA1, mi, 0, hi); partialSM(pA0, pA1, m_reg, mnA, alA, ROWON(0)); MLOAD(mA, 2);
    SLOAD(SO, KVBLK); if (2 < NT) SLOAD(SE, 2 * KVBLK);
    SWAIT(); SWRITE(1, SO); __syncthreads();
    for (int j = 1; j + 1 < NT; j += 2) {
        SBAR(); qkt(pB0, pB1, K_lds + SHM_K, qr, r32, hi);
        finishSM(pA0, pA1, alA, l_reg, pa0, pa1, pa2, pa3); SBAR();
        SLOAD(SO, (j + 2) * KVBLK); SBAR();
        pv_d0(o, vb0, pa0, pa1, pa2, pa3); mi.w = mB; apply_mask<MODE>(pB0, pB1, mi, j, hi); partialSM(pB0, pB1, m_reg, mnB, alB, ROWON(j)); MLOAD(mB, j + 2);
        __syncthreads(); SWAIT(); SWRITE(0, SE);
        RESC(alB); __syncthreads();
        SBAR(); qkt(pA0, pA1, K_lds, qr, r32, hi);
        finishSM(pB0, pB1, alB, l_reg, pa0, pa1, pa2, pa3); SBAR();
        if (j + 3 < NT) SLOAD(SE, (j + 3) * KVBLK); SBAR();
        pv_d0(o, vb0 + SHM_V, pa0, pa1, pa2, pa3); mi.w = mA; apply_mask<MODE>(pA0, pA1, mi, j + 1, hi); partialSM(pA0, pA1, m_reg, mnA, alA, ROWON(j + 1)); if (j + 3 < NT) MLOAD(mA, j + 3);
        __syncthreads(); SWAIT(); SWRITE(1, SO);
        RESC(alA); __syncthreads();
    }
    SBAR(); qkt(pB0, pB1, K_lds + SHM_K, qr, r32, hi);
    finishSM(pA0, pA1, alA, l_reg, pa0, pa1, pa2, pa3); SBAR();
    pv_d0(o, vb0, pa0, pa1, pa2, pa3); mi.w = mB; apply_mask<MODE>(pB0, pB1, mi, NT - 1, hi); partialSM(pB0, pB1, m_reg, mnB, alB, ROWON(NT - 1));
    __syncthreads(); RESC(alB);
    finishSM(pB0, pB1, alB, l_reg, pa0, pa1, pa2, pa3); SBAR();
    pv_d0(o, vb0 + SHM_V, pa0, pa1, pa2, pa3);
    if (hi == 0) li_l[r32] = l_reg; asm volatile("s_waitcnt lgkmcnt(0)" ::: "memory");
    float rli[16];
#pragma unroll
    for (int r = 0; r < 16; ++r) rli[r] = __builtin_amdgcn_rcpf(li_l[crow(r, hi)]);
    __syncthreads();
    LAS float* ost = (LAS float*)(lds + wid * 16384);
#pragma unroll
    for (int r = 0; r < 16; ++r) { const int orow = crow(r, hi);
#pragma unroll
        for (int d0 = 0; d0 < 4; ++d0) ost[orow * 128 + d0 * 32 + r32] = o[d0][r] * rli[r]; }
    asm volatile("s_waitcnt lgkmcnt(0)" ::: "memory");
    const bf16_t* Gw = Gb + (long)(wid * QBLK) * LDQ; unsigned char* Yw = Yb + (long)(wid * QBLK) * YB;
    u32x4 gg[8];
#pragma unroll
    for (int i = 0; i < 8; ++i) { const int k = lane + 64 * i, row = k >> 4, cc = (k & 15) * 8; gg[i] = *(const u32x4*)(Gw + (long)row * LDQ + cc); }
#pragma unroll
    for (int i = 0; i < 8; ++i) { const int k = lane + 64 * i, row = k >> 4, cc = (k & 15) * 8;
        const f32x4 a0 = *(const LAS f32x4*)(ost + row * 128 + cc), a1 = *(const LAS f32x4*)(ost + row * 128 + cc + 4);
        const u32x4 g = gg[i];
        const f32x4 s0 = a0 * YSC, s1 = a1 * YSC;
        *(u32x2*)(Yw + (long)row * YB + cc) = (u32x2){pk4f8(s0[0] * bflo(g.x), s0[1] * bfhi(g.x), s0[2] * bflo(g.y), s0[3] * bfhi(g.y)), pk4f8(s1[0] * bflo(g.z), s1[1] * bfhi(g.z), s1[2] * bflo(g.w), s1[3] * bfhi(g.w))}; }
    __syncthreads();
#undef SLOAD
#undef SWRITE
#undef SWAIT
#undef RESC
#undef MLOAD
#undef ROWON
}

constexpr float THR8 = 4.f;
constexpr int V8_PITCH = 80, SH_V8 = 128 * V8_PITCH, SH_K8 = 64 * 128, K8_OFF = 3 * SH_V8, WSL8_OFF = K8_OFF + 3 * SH_K8, KM8_OFF = WSL8_OFF + NW * 64 * 4;
#define KSW8(key, ch) ((key) * 128 + ((((ch) ^ (((key) >> 1) & 7))) << 4))
__device__ __forceinline__ f32x16 mfma8(i32x8 a, i32x8 b, f32x16 c) { return __builtin_amdgcn_mfma_scale_f32_32x32x64_f8f6f4(a, b, c, 0, 0, 0, 0, 0, 0); }
__device__ __forceinline__ i32x8 cat8(i32x4 a, i32x4 b) { return __builtin_shufflevector(a, b, 0, 1, 2, 3, 4, 5, 6, 7); }
__device__ __forceinline__ void partialSM8(f32x16& p0, f32x16& p1, float& m_reg, float& mn, float& alpha, bool rowon) {
    constexpr float C = SCALE * 1.4426950408889634f;
    float pmax = p0[0];
#pragma unroll
    for (int r = 1; r < 16; ++r) pmax = fmaxf(pmax, p0[r]);
#pragma unroll
    for (int r = 0; r < 16; ++r) pmax = fmaxf(pmax, p1[r]);
    { auto rr = __builtin_amdgcn_permlane32_swap(__float_as_uint(pmax), __float_as_uint(pmax), false, false);
      pmax = fmaxf(__uint_as_float(rr[0]), __uint_as_float(rr[1])); }
    pmax = rowon ? pmax : -INFINITY;
    if (__builtin_expect(__all(pmax - m_reg <= THR8 / SCALE), 1)) { mn = m_reg; alpha = 1.f; }
    else { mn = fmaxf(m_reg, pmax); alpha = __builtin_amdgcn_exp2f((m_reg - mn) * C); m_reg = mn; }
    const float mnC = rowon ? -mn * C : -INFINITY;
#pragma unroll
    for (int r = 0; r < 16; ++r) p0[r] = fmaf(p0[r], C, mnC);
#pragma unroll
    for (int r = 0; r < 16; ++r) p1[r] = fmaf(p1[r], C, mnC);
#pragma unroll
    for (int r = 0; r < 16; ++r) p0[r] = __builtin_amdgcn_exp2f(p0[r]);
}
__device__ __forceinline__ void finishSM8(f32x16& p0, f32x16& p1, float alpha, float& l_reg, i32x8& pa) {
#pragma unroll
    for (int r = 0; r < 16; ++r) p1[r] = __builtin_amdgcn_exp2f(p1[r]);
#ifdef ATT_LSUM_CHECK
    { float ps = 0;
#pragma unroll
      for (int r = 0; r < 16; ++r) ps += p0[r];
#pragma unroll
      for (int r = 0; r < 16; ++r) ps += p1[r];
      ps += __shfl_xor(ps, 32); l_reg = l_reg * alpha + ps; }
#else
    (void)alpha; (void)l_reg;
#endif
    pa = (i32x8){(int)pk4f8(p0[0], p0[1], p0[2], p0[3]), (int)pk4f8(p0[4], p0[5], p0[6], p0[7]), (int)pk4f8(p0[8], p0[9], p0[10], p0[11]), (int)pk4f8(p0[12], p0[13], p0[14], p0[15]),
                 (int)pk4f8(p1[0], p1[1], p1[2], p1[3]), (int)pk4f8(p1[4], p1[5], p1[6], p1[7]), (int)pk4f8(p1[8], p1[9], p1[10], p1[11]), (int)pk4f8(p1[12], p1[13], p1[14], p1[15])};
}
__device__ __forceinline__ void qkt8(f32x16& p0, f32x16& p1, const LAS char* k00, const LAS char* k01, const LAS char* k10, const LAS char* k11, const i32x8* q8) {
    p0 = f32x16{}; p1 = f32x16{};
    { const i32x4 a0 = *reinterpret_cast<const LAS i32x4*>(k00), a1 = *reinterpret_cast<const LAS i32x4*>(k01), b0 = *reinterpret_cast<const LAS i32x4*>(k00 + 4096), b1 = *reinterpret_cast<const LAS i32x4*>(k01 + 4096);
      p0 = mfma8(cat8(a0, a1), q8[0], p0); p1 = mfma8(cat8(b0, b1), q8[0], p1); }
    { const i32x4 a0 = *reinterpret_cast<const LAS i32x4*>(k10), a1 = *reinterpret_cast<const LAS i32x4*>(k11), b0 = *reinterpret_cast<const LAS i32x4*>(k10 + 4096), b1 = *reinterpret_cast<const LAS i32x4*>(k11 + 4096);
      p0 = mfma8(cat8(a0, a1), q8[1], p0); p1 = mfma8(cat8(b0, b1), q8[1], p1); }
}
__device__ __forceinline__ void pv8(f32x16* o, f32x16& osum, i32x8 vones, const LAS char* vr, i32x8 pa) {
    osum = mfma8(pa, vones, osum);
#pragma unroll
    for (int blk = 0; blk < 4; ++blk) { const LAS char* vp = vr + blk * 32 * V8_PITCH;
        const i32x4 v0 = *reinterpret_cast<const LAS i32x4*>(vp), v1 = *reinterpret_cast<const LAS i32x4*>(vp + 16);
        o[blk] = mfma8(pa, cat8(v0, v1), o[blk]); }
}
__device__ __forceinline__ void qk_finish8(f32x16& n0, f32x16& n1, const LAS char* k00, const LAS char* k01, const LAS char* k10, const LAS char* k11, const i32x8* q8, f32x16& p0, f32x16& p1, i32x8& pa) {
    int pw[8];
#define EXPCVT(i) do { p1[4 * (i)] = __builtin_amdgcn_exp2f(p1[4 * (i)]); p1[4 * (i) + 1] = __builtin_amdgcn_exp2f(p1[4 * (i) + 1]); p1[4 * (i) + 2] = __builtin_amdgcn_exp2f(p1[4 * (i) + 2]); p1[4 * (i) + 3] = __builtin_amdgcn_exp2f(p1[4 * (i) + 3]); \
        pw[i] = (int)pk4f8(p0[4 * (i)], p0[4 * (i) + 1], p0[4 * (i) + 2], p0[4 * (i) + 3]); pw[4 + (i)] = (int)pk4f8(p1[4 * (i)], p1[4 * (i) + 1], p1[4 * (i) + 2], p1[4 * (i) + 3]); } while (0)
    const i32x4 a0 = *reinterpret_cast<const LAS i32x4*>(k00), a1 = *reinterpret_cast<const LAS i32x4*>(k01), b0 = *reinterpret_cast<const LAS i32x4*>(k00 + 4096), b1 = *reinterpret_cast<const LAS i32x4*>(k01 + 4096);
    EXPCVT(0); SBAR();
    n0 = mfma8(cat8(a0, a1), q8[0], f32x16{});
    const i32x4 c0 = *reinterpret_cast<const LAS i32x4*>(k10), c1 = *reinterpret_cast<const LAS i32x4*>(k11), d0 = *reinterpret_cast<const LAS i32x4*>(k10 + 4096), d1 = *reinterpret_cast<const LAS i32x4*>(k11 + 4096);
    EXPCVT(1); SBAR();
    n1 = mfma8(cat8(b0, b1), q8[0], f32x16{});
    EXPCVT(2); SBAR();
    n0 = mfma8(cat8(c0, c1), q8[1], n0);
    EXPCVT(3); SBAR();
    n1 = mfma8(cat8(d0, d1), q8[1], n1);
#undef EXPCVT
    pa = (i32x8){pw[0], pw[1], pw[2], pw[3], pw[4], pw[5], pw[6], pw[7]};
    asm volatile("" : "+v"(pa));
}
template <int MODE>
__device__ __forceinline__ void pv_softmax8(f32x16* o, f32x16& osum, i32x8 vones, const LAS char* vr, i32x8 pa, f32x16& p0, f32x16& p1, const MaskInfo& mi, int j, int hi, float& m_reg, float& mn, float& alpha, bool rowon) {
    constexpr float C = SCALE * 1.4426950408889634f;
    i32x4 v0 = *reinterpret_cast<const LAS i32x4*>(vr), v1 = *reinterpret_cast<const LAS i32x4*>(vr + 16);
    osum = mfma8(pa, vones, osum);
    if (MODE == 0) apply_mask<0>(p0, p1, mi, j, hi);
    else { const unsigned w0 = mi.w.x >> (4 * hi);
#pragma unroll
        for (int r = 0; r < 16; ++r) { const int pos = (r & 3) + 8 * (r >> 2); p0[r] = bfi_f((unsigned)__builtin_amdgcn_sbfe((int)w0, pos, 1), p0[r]); } }
    SBAR();
    o[0] = mfma8(pa, cat8(v0, v1), o[0]);
    v0 = *reinterpret_cast<const LAS i32x4*>(vr + 32 * V8_PITCH); v1 = *reinterpret_cast<const LAS i32x4*>(vr + 32 * V8_PITCH + 16);
    if (MODE == 1) { const unsigned w1 = mi.w.y >> (4 * hi);
#pragma unroll
        for (int r = 0; r < 16; ++r) { const int pos = (r & 3) + 8 * (r >> 2); p1[r] = bfi_f((unsigned)__builtin_amdgcn_sbfe((int)w1, pos, 1), p1[r]); } }
    SBAR();
    o[1] = mfma8(pa, cat8(v0, v1), o[1]);
    v0 = *reinterpret_cast<const LAS i32x4*>(vr + 64 * V8_PITCH); v1 = *reinterpret_cast<const LAS i32x4*>(vr + 64 * V8_PITCH + 16);
    float pmax = p0[0];
#pragma unroll
    for (int r = 1; r < 16; ++r) pmax = fmaxf(pmax, p0[r]);
#pragma unroll
    for (int r = 0; r < 16; ++r) pmax = fmaxf(pmax, p1[r]);
    { auto rr = __builtin_amdgcn_permlane32_swap(__float_as_uint(pmax), __float_as_uint(pmax), false, false);
      pmax = fmaxf(__uint_as_float(rr[0]), __uint_as_float(rr[1])); }
    pmax = rowon ? pmax : -INFINITY;
    if (__builtin_expect(__all(pmax - m_reg <= THR8 / SCALE), 1)) { mn = m_reg; alpha = 1.f; }
    else { mn = fmaxf(m_reg, pmax); alpha = __builtin_amdgcn_exp2f((m_reg - mn) * C); m_reg = mn; }
    const float mnC = rowon ? -mn * C : -INFINITY;
    SBAR();
    o[2] = mfma8(pa, cat8(v0, v1), o[2]);
    v0 = *reinterpret_cast<const LAS i32x4*>(vr + 96 * V8_PITCH); v1 = *reinterpret_cast<const LAS i32x4*>(vr + 96 * V8_PITCH + 16);
#pragma unroll
    for (int r = 0; r < 16; ++r) p0[r] = fmaf(p0[r], C, mnC);
#pragma unroll
    for (int r = 0; r < 16; ++r) p1[r] = fmaf(p1[r], C, mnC);
    SBAR();
    o[3] = mfma8(pa, cat8(v0, v1), o[3]);
#pragma unroll
    for (int r = 0; r < 16; ++r) p0[r] = __builtin_amdgcn_exp2f(p0[r]);
    asm volatile("" : "+v"(p0), "+v"(p1));
}
template <int MODE>
__device__ __forceinline__ void attn_unit8(const bf16_t* __restrict__ Qb, const unsigned char* __restrict__ K8h, const unsigned char* __restrict__ Vt, const unsigned char* __restrict__ Gb, unsigned char* __restrict__ Yb,
                                           const float* __restrict__ km, const unsigned* __restrict__ mrow0, int qb, LAS char* lds, int wave_s, unsigned* lsum_flag = nullptr) {
    int tid_ = wave_s * 64 + lane_id_v(); asm volatile("" : "+v"(tid_));
    const int tid = tid_, wid = tid >> 6, lane = tid & 63, r32 = lane & 31, hi = lane >> 5;
    constexpr long LDQ = NPO; (void)lsum_flag;
    LAS char* V_lds = lds; LAS char* K_lds = lds + K8_OFF;
    LAS float* wsl = (LAS float*)(lds + WSL8_OFF) + wid * 64; LAS float* li_l = wsl; LAS float* al_l = wsl + 32;
    float m_reg = -1e30f, l_reg = 0; f32x16 o[4] = {}; f32x16 osum = {}; i32x8 q8[2];
    const int one8 = (r32 == 0) ? 0x38383838 : 0; const i32x8 vones = (i32x8){one8, one8, one8, one8, one8, one8, one8, one8};
    MaskInfo mi; mi.sel = 0u; mi.qrel = wid * QBLK + r32; mi.qb = qb; mi.w = (u32x2){0u, 0u};
    unsigned moff = 0u;
    {
        u32x4 qraw[2][4];
        const bf16_t* Qw = Qb + (long)(wid * QBLK + r32) * LDQ + hi * 32;
#pragma unroll
        for (int ks = 0; ks < 2; ++ks)
#pragma unroll
            for (int c = 0; c < 4; ++c) qraw[ks][c] = *reinterpret_cast<const u32x4*>(Qw + ks * 64 + c * 8);
        if (MODE == 0) {
            LAS unsigned short* kmb = (LAS unsigned short*)(lds + KM8_OFF);
            { const f32x4 kv = *(const f32x4*)(km + tid * 4); *(LAS u32x2*)(kmb + (tid >> 5) * 136 + (tid & 31) * 4) = (u32x2){pk2(kv[0], kv[1]), pk2(kv[2], kv[3])}; }
            __syncthreads();
            if (qb <= 3) mi.sel = (1u << qb) - 1u;
            else {
                f32x16 sacc = {};
#pragma unroll
                for (int ks = 0; ks < 2; ++ks)
#pragma unroll
                    for (int c = 0; c < 4; ++c) { const bf16x8 ka = *(const LAS bf16x8*)(kmb + (r32 & 15) * 136 + ks * 64 + hi * 32 + c * 8);
                        sacc = __builtin_amdgcn_mfma_f32_32x32x16_bf16(ka, __builtin_bit_cast(bf16x8, qraw[ks][c]), sacc, 0, 0, 0); }
                float own[8], oth[8];
#pragma unroll
                for (int r = 0; r < 8; ++r) { own[r] = sacc[r]; oth[r] = __shfl_xor(own[r], 32); }
                float bs[15];
#pragma unroll
                for (int n = 0; n < 15; ++n) { const int idx = (n & 3) + 4 * (n >> 3); bs[n] = (hi == ((n >> 2) & 1)) ? own[idx] : oth[idx]; }
                unsigned chosen = 0u;
#pragma unroll
                for (int rr = 0; rr < 3; ++rr) { float best = 0.f; int bi = -1;
#pragma unroll
                    for (int n = 0; n < 15; ++n) { const bool ok = (n < qb) && !((chosen >> n) & 1u) && (bi < 0 || bs[n] > best); best = ok ? bs[n] : best; bi = ok ? n : bi; }
                    chosen |= 1u << bi; }
                mi.sel = chosen;
            }
        } else {
            moff = (unsigned)(wid * QBLK + r32) * 128u;
        }
#pragma unroll
        for (int ks = 0; ks < 2; ++ks) { int w8[8];
#pragma unroll
            for (int w = 0; w < 8; ++w) { const u32x4 x = qraw[ks][w >> 1]; const unsigned lo = (w & 1) ? x.z : x.x, hi2 = (w & 1) ? x.w : x.y; w8[w] = (int)pk4f8(bflo(lo), bfhi(lo), bflo(hi2), bfhi(hi2)); }
            q8[ks] = (i32x8){w8[0], w8[1], w8[2], w8[3], w8[4], w8[5], w8[6], w8[7]}; }
    }
    const int skey = tid >> 3, sch = tid & 7, sd = tid >> 2, sq = tid & 3;
    const int kst = KSW8(skey, sch), vst = sd * V8_PITCH + 8 * (sq & 1) + 16 * (sq >> 1);
    unsigned koff = skey * 1024 + sch * 16, voff = sd * VTP + sq * 16;
    struct { u32x4 ks, vs; } sr_[2];
#define SLOAD(i, k0) do { sr_[i].ks = *reinterpret_cast<const u32x4*>(K8h + koff); sr_[i].vs = *reinterpret_cast<const u32x4*>(Vt + voff); koff += KVBLK * 1024; voff += KVBLK; asm volatile("" : "+v"(koff), "+v"(voff)); } while (0)
#define SWRITE(i) do { *(LAS u32x4*)(kW) = sr_[i].ks; *(LAS u32x2*)(vW) = (u32x2){sr_[i].vs.x, sr_[i].vs.z}; *(LAS u32x2*)(vW + 32) = (u32x2){sr_[i].vs.y, sr_[i].vs.w}; } while (0)
#define SWAIT() asm volatile("s_waitcnt vmcnt(2)" ::: "memory")
#define RESC(a) do { if (__any((a) < 1.f)) { if (hi == 0) al_l[r32] = (a); asm volatile("s_waitcnt lgkmcnt(0)" ::: "memory"); \
    _Pragma("unroll") for (int r = 0; r < 16; ++r) { const float al_ = al_l[crow(r, hi)]; osum[r] *= al_; _Pragma("unroll") for (int d = 0; d < 4; ++d) o[d][r] *= al_; } } } while (0)
#define MLOAD(dst, j) do { if (MODE == 1) { dst = *(const u32x2*)(mrow0 + moff); moff += 2u; asm volatile("" : "+v"(moff)); } } while (0)
#define ROWON(j) (MODE == 1 || ((j) >> 2) == qb || ((mi.sel >> ((j) >> 2)) & 1u))
    f32x16 pA0, pA1, pB0, pB1; float mnA, mnB, alA, alB; i32x8 pa; const int NT = 4 * (qb + 1);
    u32x2 mA = (u32x2){0u, 0u}, mB = (u32x2){0u, 0u};
    constexpr int SE = 0, SO = 1;
    MLOAD(mA, 0); MLOAD(mB, 1);
    const LAS char* kA0 = K_lds + KSW8(r32, hi * 2); const LAS char* kA1 = K_lds + KSW8(r32, hi * 2 + 1); const LAS char* kA2 = K_lds + KSW8(r32, 4 + hi * 2); const LAS char* kA3 = K_lds + KSW8(r32, 4 + hi * 2 + 1);
    const LAS char* vR = V_lds + r32 * V8_PITCH + 32 * hi; LAS char* kW = K_lds + kst; LAS char* vW = V_lds + vst;
    int bq = 0;
#define ADVW() do { kW += SH_K8; vW += SH_V8; asm volatile("" : "+v"(kW), "+v"(vW)); } while (0)
#define ADV() do { const int dp = (bq == 2) ? -2 : 1, dc = (bq == 1) ? -2 : 1, dn = (bq == 0) ? -2 : 1; bq = (bq == 2) ? 0 : bq + 1; \
        kA0 += dc * SH_K8; kA1 += dc * SH_K8; kA2 += dc * SH_K8; kA3 += dc * SH_K8; vR += dp * SH_V8; kW += dn * SH_K8; vW += dn * SH_V8; \
        asm volatile("" : "+v"(kA0), "+v"(kA1), "+v"(kA2), "+v"(kA3), "+v"(vR), "+v"(kW), "+v"(vW)); } while (0)
    SLOAD(SE, 0); asm volatile("s_waitcnt vmcnt(0)" ::: "memory"); SWRITE(SE); ADVW(); __syncthreads();
    qkt8(pA0, pA1, kA0, kA1, kA2, kA3, q8); mi.w = mA; apply_mask<MODE>(pA0, pA1, mi, 0, hi); partialSM8(pA0, pA1, m_reg, mnA, alA, ROWON(0)); MLOAD(mA, 2);
    SLOAD(SO, KVBLK); SLOAD(SE, 2 * KVBLK);
    SWAIT(); SWRITE(SO); ADVW(); __syncthreads();
    kA0 += SH_K8; kA1 += SH_K8; kA2 += SH_K8; kA3 += SH_K8;
    for (int j = 1; j + 1 < NT; j += 2) {
        SBAR(); qk_finish8(pB0, pB1, kA0, kA1, kA2, kA3, q8, pA0, pA1, pa); SBAR();
        SLOAD(SO, (j + 2) * KVBLK); SBAR();
        mi.w = mB; pv_softmax8<MODE>(o, osum, vones, vR, pa, pB0, pB1, mi, j, hi, m_reg, mnB, alB, ROWON(j)); MLOAD(mB, j + 2);
        SWRITE(SE);
        RESC(alB); __syncthreads(); ADV();
        SBAR(); qk_finish8(pA0, pA1, kA0, kA1, kA2, kA3, q8, pB0, pB1, pa); SBAR();
        SLOAD(SE, (j + 3) * KVBLK); SBAR();
        mi.w = mA; pv_softmax8<MODE>(o, osum, vones, vR, pa, pA0, pA1, mi, j + 1, hi, m_reg, mnA, alA, ROWON(j + 1)); MLOAD(mA, j + 3);
        SWRITE(SO);
        RESC(alA); __syncthreads(); ADV();
    }
    SBAR(); qk_finish8(pB0, pB1, kA0, kA1, kA2, kA3, q8, pA0, pA1, pa); SBAR();
    mi.w = mB; pv_softmax8<MODE>(o, osum, vones, vR, pa, pB0, pB1, mi, NT - 1, hi, m_reg, mnB, alB, ROWON(NT - 1));
    RESC(alB);
    vR += ((bq == 2) ? -2 : 1) * SH_V8;
    finishSM8(pB0, pB1, alB, l_reg, pa); SBAR();
    pv8(o, osum, vones, vR, pa);
#undef ADV
#undef ADVW
    if (r32 == 0) {
#pragma unroll
        for (int r = 0; r < 16; ++r) li_l[crow(r, hi)] = osum[r]; }
    asm volatile("s_waitcnt lgkmcnt(0)" ::: "memory");
#ifdef ATT_LSUM_CHECK
    { const float lm = li_l[r32]; if (!(fabsf(lm - l_reg) <= 0.03f * l_reg)) *lsum_flag = 1u; }
#endif
    float rli[16];
#pragma unroll
    for (int r = 0; r < 16; ++r) rli[r] = __builtin_amdgcn_rcpf(li_l[crow(r, hi)]);
    __syncthreads();
    LAS float* ost = (LAS float*)(lds + wid * 16384);
#pragma unroll
    for (int r = 0; r < 16; ++r) { const int orow = crow(r, hi);
#pragma unroll
        for (int d0 = 0; d0 < 4; ++d0) ost[orow * 128 + d0 * 32 + r32] = o[d0][r] * rli[r]; }
    asm volatile("s_waitcnt lgkmcnt(0)" ::: "memory");
    const unsigned char* Gw = Gb + (long)(wid * QBLK) * (LDQ * 2); unsigned char* Yw = Yb + (long)(wid * QBLK) * YB;
    u32x2 gg[8];
#pragma unroll
    for (int i = 0; i < 8; ++i) { const int k = lane + 64 * i, row = k >> 4, cc = (k & 15) * 8; gg[i] = *(const u32x2*)(Gw + (long)row * (LDQ * 2) + cc); }
#pragma unroll
    for (int i = 0; i < 8; ++i) { const int k = lane + 64 * i, row = k >> 4, cc = (k & 15) * 8;
        const f32x4 a0 = *(const LAS f32x4*)(ost + row * 128 + cc), a1 = *(const LAS f32x4*)(ost + row * 128 + cc + 4);
        const u32x2 g = gg[i];
        const auto g01 = __builtin_amdgcn_cvt_pk_f32_fp8((int)g.x, false), g23 = __builtin_amdgcn_cvt_pk_f32_fp8((int)g.x, true), g45 = __builtin_amdgcn_cvt_pk_f32_fp8((int)g.y, false), g67 = __builtin_amdgcn_cvt_pk_f32_fp8((int)g.y, true);
        const f32x4 s0 = a0 * YSC, s1 = a1 * YSC;
        *(u32x2*)(Yw + (long)row * YB + cc) = (u32x2){pk4f8(s0[0] * g01[0], s0[1] * g01[1], s0[2] * g23[0], s0[3] * g23[1]), pk4f8(s1[0] * g45[0], s1[1] * g45[1], s1[2] * g67[0], s1[3] * g67[1])}; }
    __syncthreads();
#undef SLOAD
#undef SWRITE
#undef SWAIT
#undef RESC
#undef MLOAD
#undef ROWON
}
#undef KSW8
#undef KSWZ
#undef SBAR
}

namespace tk {
using f32x16 = __attribute__((ext_vector_type(16))) float;
constexpr int CAP = 64;
constexpr int H_OFF = 0, SEL_OFF = 32768 + 256  , EQ_OFF = SEL_OFF + 16640, ST_OFF = EQ_OFF + 16640, PS_OFF = ST_OFF + 512, TK_LDS = PS_OFF + 2048, PITCH = 129;
__device__ __forceinline__ void topk_unit(const bf16_t* __restrict__ IQC, const bf16_t* __restrict__ IKC, const float* __restrict__ IDX, unsigned* __restrict__ maskw, unsigned* __restrict__ scr, int b, int ui, LAS char* lds, int wave_s, int mode = 0) {
    int tid_ = wave_s * 64 + lane_id_v(); asm volatile("" : "+v"(tid_));
    const int tid = tid_, wid = tid >> 6, lane = tid & 63, r32 = lane & 31, hi = lane >> 5;
    LAS unsigned* hist = (LAS unsigned*)(lds + H_OFF); LAS unsigned* selb = (LAS unsigned*)(lds + SEL_OFF); LAS unsigned* eqb = (LAS unsigned*)(lds + EQ_OFF);
    LAS unsigned* st = (LAS unsigned*)(lds + ST_OFF); LAS unsigned* psum = (LAS unsigned*)(lds + PS_OFF);
    const int pos0 = ui * 32; const size_t tokq = (size_t)b * SEQ + pos0 + r32;
    bf16x8 bq[4][4];
#pragma unroll
    for (int j = 0; j < 4; ++j)
#pragma unroll
        for (int kk = 0; kk < 4; ++kk) bq[j][kk] = *reinterpret_cast<const bf16x8*>(IQC + tokq * 256 + j * 64 + kk * 16 + hi * 8);
    float wj[4];
#pragma unroll
    for (int j = 0; j < 4; ++j) wj[j] = IDX[tokq * 4 + j] * 0.0625f;
    for (int i = tid; i < 8192; i += 512) hist[i] = 0u;
    for (int i = tid; i < 32 * PITCH; i += 512) selb[i] = 0u;
    if (tid < 32) { st[tid] = 0u; const int n = pos0 + tid + 1; st[32 + tid] = (unsigned)(n < 256 ? n : 256); st[64 + tid] = 0u; if (tid == 0) { st[96] = (mode == 1) ? 1u : 0u; st[97] = 0u; } }
    __syncthreads();
    const int ntile = ui + 1;
    const bf16_t* kbase = IKC + ((size_t)b * SEQ + r32) * 64 + hi * 8;
    u32x4* scr4 = (u32x4*)scr + lane;
#ifndef PROBE_TK
#define PROBE_TK 0
#endif
    for (int rp0 = 0; rp0 < (PROBE_TK == 1 ? 2 : 1); ++rp0) {
        if (rp0) { __syncthreads(); for (int i = tid; i < 8192; i += 512) hist[i] = 0u; __syncthreads(); }
        bf16x8 an[4], an2[4];
        if (wid < ntile) {
#pragma unroll
            for (int kk = 0; kk < 4; ++kk) an[kk] = *reinterpret_cast<const bf16x8*>(kbase + (size_t)(wid * 32) * 64 + kk * 16);
        }
        if (wid + 8 < ntile) {
#pragma unroll
            for (int kk = 0; kk < 4; ++kk) an2[kk] = *reinterpret_cast<const bf16x8*>(kbase + (size_t)((wid + 8) * 32) * 64 + kk * 16);
        }
        for (int tile = wid; tile < ntile; tile += 8) {
            bf16x8 a[4];
#pragma unroll
            for (int kk = 0; kk < 4; ++kk) { a[kk] = an[kk]; an[kk] = an2[kk]; }
            if (tile + 16 < ntile) {
#pragma unroll
                for (int kk = 0; kk < 4; ++kk) an2[kk] = *reinterpret_cast<const bf16x8*>(kbase + (size_t)((tile + 16) * 32) * 64 + kk * 16);
            }
            f32x16 acc[4];
#pragma unroll
            for (int j = 0; j < 4; ++j) { acc[j] = f32x16{};
#pragma unroll
                for (int kk = 0; kk < 4; ++kk) acc[j] = __builtin_amdgcn_mfma_f32_32x32x16_bf16(a[kk], bq[j][kk], acc[j], 0, 0, 0); }
            const bool diag = (tile == ui);
            unsigned keys[16];
#define TK_KEY(r) float sc = wj[0] * relu_i(acc[0][r]); sc = fmaf(wj[1], relu_i(acc[1][r]), sc); sc = fmaf(wj[2], relu_i(acc[2][r]), sc); sc = fmaf(wj[3], relu_i(acc[3][r]), sc); \
                sc = sc + 0.0f; const unsigned u = __float_as_uint(sc); const unsigned key = u ^ ((unsigned)((int)u >> 31) | 0x80000000u); keys[r] = key
            if (!diag) {
#pragma unroll
                for (int r = 0; r < 16; ++r) { TK_KEY(r); atomicAdd((unsigned*)&hist[(key >> 24) * 32 + r32], 1u); }
            } else {
#pragma unroll
                for (int r = 0; r < 16; ++r) { TK_KEY(r);
                    const int kk_ = (r & 3) + 8 * (r >> 2) + 4 * hi;
                    const bool valid = kk_ <= r32;
                    atomicAdd((unsigned*)&hist[(valid ? (key >> 24) : 256u) * 32 + r32], 1u); }
            }
#undef TK_KEY
#pragma unroll
            for (int j = 0; j < 4; ++j) scr4[(size_t)(tile * 4 + j) * 64] = (u32x4){keys[4 * j], keys[4 * j + 1], keys[4 * j + 2], keys[4 * j + 3]};
        }
    }
    __syncthreads();
    bool short_done = false;
    for (int pass = 0; pass < 5; ++pass) {
        if (pass == 2 && st[96] == 0u) {
            LAS unsigned* clist = hist; LAS unsigned* ccnt = psum;
            if (tid < 32) ccnt[tid] = 0u;
            const unsigned pfx16 = st[r32];
            const bool zm = st[64 + r32] > (unsigned)CAP;
            bool bad = false;
            for (int base = wid; base < ntile; base += 16) {
                u32x4 kb[2][4];
#pragma unroll
                for (int t8 = 0; t8 < 2; ++t8) { const int tile = base + 8 * t8;
                    if (tile < ntile) {
#pragma unroll
                        for (int j = 0; j < 4; ++j) kb[t8][j] = scr4[(size_t)(tile * 4 + j) * 64]; } }
#pragma unroll
                for (int t8 = 0; t8 < 2; ++t8) { const int tile = base + 8 * t8;
                    if (tile < ntile) {
                        unsigned gtw = 0u, eqw = 0u;
                        if (tile != ui) {
#pragma unroll
                            for (int r = 0; r < 16; ++r) {
                                const unsigned key = kb[t8][r >> 2][r & 3];
                                const int kk_ = (r & 3) + 8 * (r >> 2) + 4 * hi;
                                gtw |= ((key >> 16) > pfx16) ? (1u << kk_) : 0u; eqw |= ((key >> 16) == pfx16) ? (1u << kk_) : 0u;
                                bad |= zm && (key >> 16) == pfx16 && key != 0x80000000u;
                            }
                        } else {
#pragma unroll
                            for (int r = 0; r < 16; ++r) {
                                const unsigned key = kb[t8][r >> 2][r & 3];
                                const int kk_ = (r & 3) + 8 * (r >> 2) + 4 * hi;
                                const bool valid = kk_ <= r32;
                                gtw |= (valid && (key >> 16) > pfx16) ? (1u << kk_) : 0u; eqw |= (valid && (key >> 16) == pfx16) ? (1u << kk_) : 0u;
                                bad |= zm && valid && (key >> 16) == pfx16 && key != 0x80000000u;
                            }
                        }
                        gtw |= __shfl_xor(gtw, 32); eqw |= __shfl_xor(eqw, 32); if (hi == 0) { selb[r32 * PITCH + tile] = gtw; eqb[r32 * PITCH + tile] = eqw; }
                    } }
            }
            if (__builtin_amdgcn_ballot_w64(bad) != 0ull && lane == 0) st[97] = 1u;
            __syncthreads();
            if (st[97] == 0u) {
            { const int q = tid >> 4, c16 = tid & 15;
              if (st[64 + q] <= (unsigned)CAP)
              for (int tile = c16; tile < ntile; tile += 16) { unsigned ee = eqb[q * PITCH + tile];
                  while (ee) { const int kk_ = __builtin_ctz(ee); ee &= ee - 1u;
                      const int r = (kk_ & 3) + 4 * (kk_ >> 3), ln = q + 32 * ((kk_ >> 2) & 1);
                      const unsigned key = __hip_atomic_load(scr + ((size_t)(tile * 4 + (r >> 2)) * 64 + ln) * 4 + (r & 3), __ATOMIC_RELAXED, __HIP_MEMORY_SCOPE_AGENT);
                      const unsigned slot = atomicAdd((unsigned*)&ccnt[q], 1u);
                      if (slot < (unsigned)CAP) clist[q * CAP + slot] = ((key & 0xffffu) << 16) | (0xffffu - (unsigned)(tile * 32 + kk_)); } } }
            __syncthreads();
            { const int q = tid >> 4; const unsigned cnt = ccnt[q] < (unsigned)CAP ? ccnt[q] : (unsigned)CAP, need = st[32 + q];
              for (unsigned i = (unsigned)(tid & 15); i < cnt; i += 16u) { const unsigned v = clist[q * CAP + i]; unsigned rank = 0u;
                  for (unsigned j = 0; j < cnt; ++j) rank += (clist[q * CAP + j] > v) ? 1u : 0u;
                  if (rank < need) { const unsigned kpos = 0xffffu - (v & 0xffffu); atomicOr((unsigned*)&selb[q * PITCH + (kpos >> 5)], 1u << (kpos & 31u)); } } }
            if (tid < 32 && st[64 + tid] > (unsigned)CAP) {
                const int q = tid; const unsigned need = st[32 + q]; unsigned seen = 0u;
                for (int tile = 0; tile <= ui && seen < need; ++tile) { const unsigned e = eqb[q * PITCH + tile];
                    if (e) { const unsigned k = (unsigned)__builtin_popcount(e);
                        if (seen + k <= need) { selb[q * PITCH + tile] |= e; seen += k; }
                        else { const unsigned keep = need - seen; unsigned km = 0u, ee = e; for (unsigned i = 0; i < keep; ++i) { const unsigned low = ee & (0u - ee); km |= low; ee ^= low; }
                            selb[q * PITCH + tile] |= km; seen = need; } } } }
            short_done = true;
            break;
            }
        }
        if (pass > 0) {
            const unsigned prefix = st[r32];
            const int sh = 24 - 8 * (pass < 4 ? pass : 3);
            if (pass < 4) {
                for (int base = wid; base < ntile; base += 32) {
                    u32x4 kb[4][4];
#pragma unroll
                    for (int t8 = 0; t8 < 4; ++t8) { const int tile = base + 8 * t8;
                        if (tile < ntile) {
#pragma unroll
                            for (int j = 0; j < 4; ++j) kb[t8][j] = scr4[(size_t)(tile * 4 + j) * 64]; } }
#pragma unroll
                    for (int t8 = 0; t8 < 4; ++t8) { const int tile = base + 8 * t8;
                        if (tile < ntile) {
                            if (tile != ui) {
#pragma unroll
                                for (int r = 0; r < 16; ++r) {
                                    const unsigned key = kb[t8][r >> 2][r & 3];
                                    const bool match = ((key >> (sh + 8)) == prefix);
                                    atomicAdd((unsigned*)&hist[(match ? ((key >> sh) & 255u) : 256u) * 32 + r32], 1u);
                                }
                            } else {
#pragma unroll
                                for (int r = 0; r < 16; ++r) {
                                    const unsigned key = kb[t8][r >> 2][r & 3];
                                    const int kk_ = (r & 3) + 8 * (r >> 2) + 4 * hi;
                                    const bool match = (kk_ <= r32) && ((key >> (sh + 8)) == prefix);
                                    atomicAdd((unsigned*)&hist[(match ? ((key >> sh) & 255u) : 256u) * 32 + r32], 1u);
                                }
                            }
                        } }
                }
            } else {
                for (int base = wid; base < ntile; base += 32) {
                    u32x4 kb[4][4];
#pragma unroll
                    for (int t8 = 0; t8 < 4; ++t8) { const int tile = base + 8 * t8;
                        if (tile < ntile) {
#pragma unroll
                            for (int j = 0; j < 4; ++j) kb[t8][j] = scr4[(size_t)(tile * 4 + j) * 64]; } }
#pragma unroll
                    for (int t8 = 0; t8 < 4; ++t8) { const int tile = base + 8 * t8;
                        if (tile < ntile) {
                            const bool diag = (tile == ui);
                            unsigned gtw = 0u, eqw = 0u;
#pragma unroll
                            for (int r = 0; r < 16; ++r) {
                                const unsigned key = kb[t8][r >> 2][r & 3];
                                const int kk_ = (r & 3) + 8 * (r >> 2) + 4 * hi;
                                const bool valid = !diag || kk_ <= r32;
                                gtw |= (valid && key > prefix) ? (1u << kk_) : 0u; eqw |= (valid && key == prefix) ? (1u << kk_) : 0u;
                            }
                            gtw |= __shfl_xor(gtw, 32); eqw |= __shfl_xor(eqw, 32); if (hi == 0) { selb[r32 * PITCH + tile] = gtw | eqw; eqb[r32 * PITCH + tile] = eqw; }
                        } }
                }
            }
            __syncthreads();
        }
        if (pass < 4) {
            const int q = tid & 31, part = tid >> 5;
            unsigned c[16]; unsigned lsum = 0u;
#pragma unroll
            for (int i = 0; i < 16; ++i) { c[i] = hist[(16 * part + i) * 32 + q]; lsum += c[i]; }
            const unsigned needq = st[32 + q], pfx = st[q];
            psum[part * 32 + q] = lsum;
            __syncthreads();
            unsigned above = 0u;
            for (int p2 = part + 1; p2 < 16; ++p2) above += psum[p2 * 32 + q];
            if (above < needq && needq <= above + lsum) {
                bool done = false;
#pragma unroll
                for (int i = 15; i >= 0; --i) { if (!done) { if (above + c[i] >= needq) { st[q] = (pfx << 8) | (unsigned)(16 * part + i); st[32 + q] = needq - above; st[64 + q] = c[i]; if (pass == 1 && c[i] > (unsigned)CAP && ((pfx << 8) | (unsigned)(16 * part + i)) != 0x8000u) st[96] = 1u;     done = true; } else above += c[i]; } }
            }
#pragma unroll
            for (int i = 0; i < 16; ++i) hist[(16 * part + i) * 32 + q] = 0u;
            __syncthreads();
        }
    }
    if (!short_done && tid < 32) { const int q = tid; const unsigned need = st[32 + q], cnt = st[64 + q];
        if (cnt > need) { unsigned seen = 0u;
            for (int tile = 0; tile <= ui; ++tile) { const unsigned e = eqb[q * PITCH + tile];
                if (e) { const unsigned k = (unsigned)__builtin_popcount(e);
                    if (seen + k <= need) seen += k;
                    else { const unsigned keep = need - seen; unsigned km = 0u, ee = e; for (unsigned i = 0; i < keep; ++i) { const unsigned low = ee & (0u - ee); km |= low; ee ^= low; }
                        selb[q * PITCH + tile] &= ~(e & ~km); seen = need; } } } } }
    __syncthreads();
    { const int q = tid >> 4, c = tid & 15;
      if (c <= (ui >> 3)) { u32x4 w0, w1; const LAS unsigned* sp = selb + q * PITCH + 8 * c;
          w0.x = sp[0]; w0.y = sp[1]; w0.z = sp[2]; w0.w = sp[3]; w1.x = sp[4]; w1.y = sp[5]; w1.z = sp[6]; w1.w = sp[7];
          unsigned* gp = maskw + ((size_t)b * SEQ + pos0 + q) * 128 + 8 * c; *(u32x4*)gp = w0; *(u32x4*)(gp + 4) = w1; } }
    __syncthreads();
}
}
#define XB_TMO      128
#define XB_XCNT(j)  (256  + 64 * (j))
#define XB_XSUB(j)  (1280 + 64 * (j))
#define XB_XGEN(j)  (2304 + 64 * (j))
#define XB_TOP      3328
#define XB_TOPGEN   3392
#define XCD_BAR_WORDS 3456
#define XB_SPIN_CAP (1u << 18)
__device__ __forceinline__ unsigned xb_ld(unsigned* p)              { return __hip_atomic_load(p, __ATOMIC_RELAXED, __HIP_MEMORY_SCOPE_AGENT); }
__device__ __forceinline__ unsigned xb_add(unsigned* p, unsigned v) { return __hip_atomic_fetch_add(p, v, __ATOMIC_RELAXED, __HIP_MEMORY_SCOPE_AGENT); }
__device__ __forceinline__ unsigned xb_xcc_id() { return (unsigned)__builtin_amdgcn_s_getreg((3 << 11) | 20) & 0xFu; }
#define XB_SPIN(cond, bar) do { unsigned _sp = 0; while (cond) { __builtin_amdgcn_s_sleep(1); \
    if ((++_sp & 255u) == 0u) { if (xb_ld(&(bar)[XB_TMO])) break; if (_sp > XB_SPIN_CAP) { atomicAdd(&(bar)[XB_TMO], 1u); break; } } } } while (0)
struct XcdBarrier { unsigned* bar; unsigned x; volatile LAS unsigned* st; };
__device__ __forceinline__ XcdBarrier xcd_barrier_post(unsigned* bar, volatile LAS unsigned* st, bool t0) {
    XcdBarrier b; b.bar = bar; b.x = xb_xcc_id(); b.st = st;
    if (t0) (void)xb_add(&bar[XB_XCNT(b.x)], 1u);
    return b;
}
__device__ __forceinline__ void xcd_barrier_complete(unsigned* bar, unsigned x, unsigned& nloc, unsigned& nx) {
    const unsigned G = gridDim.x * gridDim.y * gridDim.z;
    unsigned sum, cnt, mine, sp = 0u;
    for (;;) {
        sum = 0u; cnt = 0u; mine = 0u;
#pragma unroll
        for (unsigned j = 0; j < 16; ++j) { const unsigned c = xb_ld(&bar[XB_XCNT(j)]); sum += c; cnt += (c > 0u) ? 1u : 0u; mine = (j == x) ? c : mine; }
        if (sum == G) break;
        __builtin_amdgcn_s_sleep(1);
        if ((++sp & 255u) == 0u) { if (xb_ld(&bar[XB_TMO])) break; if (sp > XB_SPIN_CAP) { atomicAdd(&bar[XB_TMO], 1u); break; } }
    }
    nloc = mine > 0u ? mine : 1u; nx = cnt > 0u ? cnt : 1u;
}
__device__ __forceinline__ void xcd_barrier_(const XcdBarrier& b, bool t0) {
    asm volatile("s_waitcnt vmcnt(0)" ::: "memory");
    __syncthreads();
    if (t0) {
        unsigned* bar = b.bar;
        __builtin_amdgcn_s_waitcnt(0);
        unsigned nloc = b.st[0], nx = b.st[1];
        if (nloc == 0u) { xcd_barrier_complete(bar, b.x, nloc, nx); b.st[0] = nloc; b.st[1] = nx; }
        const unsigned old = xb_add(&bar[XB_XSUB(b.x)], 1u);
        const unsigned gen = old / nloc;
        if (old + 1u == (gen + 1u) * nloc) {
            __builtin_amdgcn_fence(__ATOMIC_RELEASE, "agent");
            asm volatile("s_waitcnt vmcnt(0)" ::: "memory");
            const unsigned og = xb_add(&bar[XB_TOP], 1u);
            const unsigned tg = og / nx;
            if (og + 1u == (tg + 1u) * nx) xb_add(&bar[XB_TOPGEN], 1u);
            else XB_SPIN(xb_ld(&bar[XB_TOPGEN]) == tg, bar);
            __builtin_amdgcn_fence(__ATOMIC_ACQUIRE, "agent");
            xb_add(&bar[XB_XGEN(b.x)], 1u);
            asm volatile("s_waitcnt vmcnt(0)" ::: "memory");
        } else {
            XB_SPIN(xb_ld(&bar[XB_XGEN(b.x)]) == gen, bar);
            __builtin_amdgcn_fence(__ATOMIC_ACQUIRE, "agent");
            asm volatile("s_waitcnt vmcnt(0)" ::: "memory");
        }
    }
    __syncthreads();
}

constexpr int NWAVES = 8;
constexpr int RING_OFF = 0, RING_BYTES = 131072, MISC_OFF = RING_BYTES + 320, LUT_OFF = RING_BYTES + 9216  , LDS_BYTES = 147456;
#define LDS_WAIT() asm volatile("s_waitcnt lgkmcnt(0)" ::: "memory")

struct Args {
    const float *x, *mem, *ln_g, *w_in, *conv_w, *conv_b, *mem_ln_g, *w_mem_kv, *w_branch, *w_out, *final_g;
    float* out; unsigned char* ws; int ph_lo, ph_hi;
};

__device__ __forceinline__ float wave_sum(float v) {
#pragma unroll
    for (int o = 1; o < 64; o <<= 1) v += __shfl_xor(v, o);
    return v;
}
struct TrItem { const float* src; bf16_t* dst; int ldw, ldo; bool valid, f8; };
__device__ __forceinline__ void tr_load(const TrItem& it, f32x4 (&v)[16], int lane) {
    const float* p = it.src + (size_t)(lane >> 4) * it.ldw + (lane & 15) * 4;
#pragma unroll
    for (int i = 0; i < 16; ++i) v[i] = it.valid ? *(const f32x4*)(p + (size_t)(4 * i) * it.ldw) : (f32x4){0.f, 0.f, 0.f, 0.f};
}
__device__ __forceinline__ void tr_store(const TrItem& it, const f32x4 (&v)[16], LAS unsigned char* scr, int lane) {
    const int kr = lane >> 4, l16 = lane & 15;
#pragma unroll
    for (int i = 0; i < 16; ++i) *(LAS u32x2*)(scr + (4 * i + kr) * 128 + l16 * 8) = (u32x2){pk2(v[i].x, v[i].y), pk2(v[i].z, v[i].w)};
    asm volatile("s_waitcnt lgkmcnt(0)" ::: "memory");
    const int g = lane >> 4, q = (lane >> 2) & 3, p = lane & 3;
    const unsigned rb = (unsigned)(uintptr_t)scr + q * 128 + 32 * g + 8 * p;
    LAS unsigned char* ot = scr + 8192;
    const int nn = 16 * g + l16;
#pragma unroll
    for (int c = 0; c < 8; ++c) { u32x2 lo, hi;
        asm volatile("ds_read_b64_tr_b16 %0, %1 offset:%2" : "=&v"(lo) : "v"(rb), "i"(c * 1024) : "memory");
        asm volatile("ds_read_b64_tr_b16 %0, %1 offset:%2" : "=&v"(hi) : "v"(rb), "i"(c * 1024 + 512) : "memory");
        asm volatile("s_waitcnt lgkmcnt(0)" ::: "memory"); __builtin_amdgcn_sched_barrier(0);
        *(LAS u32x4*)(ot + nn * 128 + ((c ^ (nn & 7)) << 4)) = (u32x4){lo.x, lo.y, hi.x, hi.y}; }
    asm volatile("s_waitcnt lgkmcnt(0)" ::: "memory");
    const int cc = lane & 7;
#pragma unroll
    for (int j = 0; j < 8; ++j) { const int n2 = (lane >> 3) + 8 * j;
        const u32x4 v4 = *(const LAS u32x4*)(ot + n2 * 128 + ((cc ^ (n2 & 7)) << 4));
        if (it.f8) *(u32x2*)((unsigned char*)it.dst + (size_t)n2 * it.ldo + 8 * cc) = (u32x2){pk4f8(bflo(v4.x) * WSC, bfhi(v4.x) * WSC, bflo(v4.y) * WSC, bfhi(v4.y) * WSC), pk4f8(bflo(v4.z) * WSC, bfhi(v4.z) * WSC, bflo(v4.w) * WSC, bfhi(v4.w) * WSC)};
        else *(u32x4*)(it.dst + (size_t)n2 * it.ldo + 8 * cc) = v4; }
    asm volatile("s_waitcnt lgkmcnt(0)" ::: "memory");
}
__device__ __forceinline__ float wave_max(float v) {
#pragma unroll
    for (int o = 1; o < 64; o <<= 1) v = fmaxf(v, __shfl_xor(v, o));
    return v;
}
__device__ __forceinline__ unsigned q8x4(float a, float b, float c, float d) {
    const unsigned ua = __builtin_bit_cast(unsigned, a + 12582912.0f), ub = __builtin_bit_cast(unsigned, b + 12582912.0f), uc = __builtin_bit_cast(unsigned, c + 12582912.0f), ud = __builtin_bit_cast(unsigned, d + 12582912.0f);
    return (ua & 0xffu) | ((ub & 0xffu) << 8) | ((uc & 0xffu) << 16) | (ud << 24);
}
template <bool OUTF, int NR, bool INB = false>
__device__ __forceinline__ void rms_rows(const float* xrow, size_t xstride, const float* g, void* orow, size_t ostride_bytes, int lane, unsigned char* q8row = nullptr, size_t q8stride = 0, float* sarow = nullptr, size_t sastride = 0, unsigned char* q4row = nullptr, size_t q4stride = 0, float* sa4row = nullptr) {
    f32x4 v[NR][8]; float s[NR];
#pragma unroll
    for (int r = 0; r < NR; ++r) {
        if constexpr (INB) { const u32x2* xr = (const u32x2*)((const bf16_t*)xrow + r * xstride) + lane;
#pragma unroll
            for (int j = 0; j < 8; ++j) { const u32x2 w = xr[64 * j]; v[r][j] = (f32x4){bflo(w.x), bfhi(w.x), bflo(w.y), bfhi(w.y)}; } }
        else { const f32x4* xr = (const f32x4*)(xrow + r * xstride) + lane;
#pragma unroll
            for (int j = 0; j < 8; ++j) v[r][j] = xr[64 * j]; } }
    const f32x4* gr = (const f32x4*)g + lane;
    f32x4 gg8[8];
#pragma unroll
    for (int j = 0; j < 8; ++j) gg8[j] = gr[64 * j];
#pragma unroll
    for (int r = 0; r < NR; ++r) { float a = 0.f;
#pragma unroll
        for (int j = 0; j < 8; ++j) a += (v[r][j].x * v[r][j].x + v[r][j].y * v[r][j].y) + (v[r][j].z * v[r][j].z + v[r][j].w * v[r][j].w);
        s[r] = 1.0f / sqrtf(wave_sum(a) * (1.f / DM) + EPS); }
#pragma unroll
    for (int j = 0; j < 8; ++j) { const f32x4 gg = gg8[j];
#pragma unroll
        for (int r = 0; r < NR; ++r) { const f32x4 y = (f32x4){v[r][j].x * s[r] * gg.x, v[r][j].y * s[r] * gg.y, v[r][j].z * s[r] * gg.z, v[r][j].w * s[r] * gg.w};
            v[r][j] = y;
            unsigned char* ob = (unsigned char*)orow + r * ostride_bytes;
            if (OUTF) ((f32x4*)ob)[lane + 64 * j] = y;
            else ((u32x2*)ob)[lane + 64 * j] = (u32x2){pk2(y.x, y.y), pk2(y.z, y.w)}; } }
    if (!OUTF && q8row != nullptr) {
#pragma unroll
        for (int r = 0; r < NR; ++r) { float am = 0.f;
#pragma unroll
            for (int j = 0; j < 8; ++j) am = fmaxf(am, fmaxf(fmaxf(fabsf(v[r][j].x), fabsf(v[r][j].y)), fmaxf(fabsf(v[r][j].z), fabsf(v[r][j].w))));
            am = fmaxf(wave_max(am), 1e-30f);
            const float inv = 127.0f / am;
            unsigned* qb = (unsigned*)(q8row + r * q8stride);
#pragma unroll
            for (int j = 0; j < 8; ++j) qb[lane + 64 * j] = q8x4(v[r][j].x * inv, v[r][j].y * inv, v[r][j].z * inv, v[r][j].w * inv);
            if (lane == 0) sarow[r * sastride] = am * (1.0f / 127.0f);
            if (q4row != nullptr) {
                const float inv4 = 6.0f / am; unsigned short* q4 = (unsigned short*)(q4row + r * q4stride);
#pragma unroll
                for (int j = 0; j < 8; ++j) { unsigned w = 0u; w = __builtin_amdgcn_cvt_scalef32_pk_fp4_f32(w, v[r][j].x * inv4, v[r][j].y * inv4, 1.0f, 0); w = __builtin_amdgcn_cvt_scalef32_pk_fp4_f32(w, v[r][j].z * inv4, v[r][j].w * inv4, 1.0f, 1); q4[lane + 64 * j] = (unsigned short)w; }
                if (lane == 0) sa4row[r * sastride] = am * (1.0f / 6.0f); } }
    }
}
template <bool OUTF>
__device__ __forceinline__ void rms_row(const float* xrow, const float* g, void* orow, int lane) { rms_rows<OUTF, 1>(xrow, 0, g, orow, 0, lane); }

__device__ __forceinline__ void kmean_pair(const unsigned char* K8, float* kmean, int u0, int u1, int wave, int lane, LAS float* red) {
    const int u = (wave < 4) ? u0 : u1, p = wave & 3, dg = lane & 15, rg = lane >> 4;
    float s[8] = {0.f, 0.f, 0.f, 0.f, 0.f, 0.f, 0.f, 0.f};
    if (u >= 0) {
        const int blk = u & 15, h = (u >> 4) & 7, b = u >> 7;
        const unsigned char* ptr = K8 + (size_t)(b * SEQ + blk * 256 + p * 64 + rg) * 1024 + h * 128 + dg * 8;
        u32x2 w[16];
#pragma unroll
        for (int k = 0; k < 16; ++k) w[k] = *(const u32x2*)(ptr + (size_t)(4 * k) * 1024);
#pragma unroll
        for (int k = 0; k < 16; ++k) { const f32x2 a = __builtin_amdgcn_cvt_pk_f32_fp8((int)w[k].x, false), b2 = __builtin_amdgcn_cvt_pk_f32_fp8((int)w[k].x, true), c = __builtin_amdgcn_cvt_pk_f32_fp8((int)w[k].y, false), d = __builtin_amdgcn_cvt_pk_f32_fp8((int)w[k].y, true);
            s[0] += a[0]; s[1] += a[1]; s[2] += b2[0]; s[3] += b2[1]; s[4] += c[0]; s[5] += c[1]; s[6] += d[0]; s[7] += d[1]; }
#pragma unroll
        for (int i = 0; i < 8; ++i) { s[i] += __shfl_xor(s[i], 16); s[i] += __shfl_xor(s[i], 32); }
    }
    if (rg == 0) { LAS float* o = red + wave * 128 + dg * 8;
#pragma unroll
        for (int i = 0; i < 8; ++i) o[i] = s[i]; }
    __syncthreads();
    if (p == 0 && u >= 0 && rg < 2) {
        const int d4 = (lane & 31) * 4; const LAS float* r0 = red + wave * 128 + d4;
        f32x4 t = *(const LAS f32x4*)r0 + *(const LAS f32x4*)(r0 + 128) + *(const LAS f32x4*)(r0 + 256) + *(const LAS f32x4*)(r0 + 384);
        *(f32x4*)(kmean + (size_t)u * 128 + d4) = t * (1.0f / 256.0f); }
    __syncthreads();
}
__device__ __forceinline__ void mul8(const u32x4 a, const u32x4 b, float (&o)[8]) {
    o[0] = bflo(a.x) * bflo(b.x); o[1] = bfhi(a.x) * bfhi(b.x); o[2] = bflo(a.y) * bflo(b.y); o[3] = bfhi(a.y) * bfhi(b.y);
    o[4] = bflo(a.z) * bflo(b.z); o[5] = bfhi(a.z) * bfhi(b.z); o[6] = bflo(a.w) * bflo(b.w); o[7] = bfhi(a.w) * bfhi(b.w); }
__device__ __forceinline__ void bf8x(const u32x4 a, float (&o)[8]) { o[0] = bflo(a.x); o[1] = bfhi(a.x); o[2] = bflo(a.y); o[3] = bfhi(a.y); o[4] = bflo(a.z); o[5] = bfhi(a.z); o[6] = bflo(a.w); o[7] = bfhi(a.w); }
__device__ __forceinline__ void conv_phase(const bf16_t* PO, const float* cw, const float* cbias, unsigned char* Y, int gtid, int nthr) {
    const int c = (gtid & 127) * 8;
    float k0[8], k1[8], k2[8], kb[8];
#pragma unroll
    for (int i = 0; i < 8; ++i) { k0[i] = cw[c + i]; k1[i] = cw[BW + c + i]; k2[i] = cw[2 * BW + c + i]; kb[i] = cbias[c + i]; }
    for (int it = gtid; it < M * 128; it += nthr) {
        const int t = it >> 7, pos = t & (SEQ - 1);
        const bf16_t* r0 = PO + (size_t)t * NPO;
        const u32x4 w2 = *(const u32x4*)(r0 + C_CC + c), w1 = *(const u32x4*)(r0 - (pos >= 1 ? NPO : 0) + C_CC + c), w0 = *(const u32x4*)(r0 - (pos >= 2 ? 2 * (size_t)NPO : 0) + C_CC + c), wb = *(const u32x4*)(r0 + C_CB + c);
        float u2[8], u1[8], u0[8], bg[8];
        bf8x(w2, u2); bf8x(w1, u1); bf8x(w0, u0); bf8x(wb, bg);
        if (pos < 1) { for (int i = 0; i < 8; ++i) u1[i] = 0.f; }
        if (pos < 2) { for (int i = 0; i < 8; ++i) u0[i] = 0.f; }
        float y[8];
#pragma unroll
        for (int i = 0; i < 8; ++i) y[i] = (k0[i] * u0[i] + k1[i] * u1[i] + k2[i] * u2[i] + kb[i]) * bg[i];
        *(u32x4*)(Y + (size_t)t * YB + 3072 + 2 * c) = (u32x4){pk2(y[0], y[1]), pk2(y[2], y[3]), pk2(y[4], y[5]), pk2(y[6], y[7])};
    }
}
__device__ __forceinline__ void quant_strip(const float* __restrict__ src  , unsigned char* __restrict__ w8, float* __restrict__ sb, LAS unsigned char* img, LAS float* red, int wave, int lane, int nvalid, bool f4, unsigned char* __restrict__ w4, float* __restrict__ sb4) {
    constexpr int SP = 4100;
    const int rp = lane >> 3, c4 = lane & 7;
    const float* p = src + (size_t)(256 * wave + 2 * rp) * NIN;
    f32x4 e[16], o[16];
    const bool cv = (4 * c4 < nvalid);
#pragma unroll
    for (int i = 0; i < 16; ++i) { const float* q = p + (size_t)(16 * i) * NIN; e[i] = cv ? *(const f32x4*)q : (f32x4){0.f, 0.f, 0.f, 0.f}; o[i] = cv ? *(const f32x4*)(q + NIN) : (f32x4){0.f, 0.f, 0.f, 0.f}; }
    float am[4] = {0.f, 0.f, 0.f, 0.f};
    LAS unsigned char* wb = img + (4 * c4) * SP + (256 * wave + 2 * rp) * 2;
#pragma unroll
    for (int i = 0; i < 16; ++i)
#pragma unroll
        for (int c = 0; c < 4; ++c) { am[c] = fmaxf(am[c], fmaxf(fabsf(e[i][c]), fabsf(o[i][c]))); *(LAS unsigned*)(wb + c * SP + 32 * i) = pk2(e[i][c], o[i][c]); }
#pragma unroll
    for (int c = 0; c < 4; ++c) { am[c] = fmaxf(am[c], __shfl_xor(am[c], 8)); am[c] = fmaxf(am[c], __shfl_xor(am[c], 16)); am[c] = fmaxf(am[c], __shfl_xor(am[c], 32)); }
    if (rp == 0) { *(LAS f32x4*)(red + wave * 32 + 4 * c4) = (f32x4){am[0], am[1], am[2], am[3]}; }
    asm volatile("s_waitcnt lgkmcnt(0)" ::: "memory");
    __syncthreads();
#pragma unroll
    for (int i = 0; i < 4; ++i) { const int n = 4 * wave + i;
        float m = red[n];
#pragma unroll
        for (int w2 = 1; w2 < 8; ++w2) m = fmaxf(m, red[w2 * 32 + n]);
        m = fmaxf(m, 1e-30f); const float inv = (f4 ? 6.0f : 127.0f) / m;
        const LAS unsigned* rd = (const LAS unsigned*)(img + n * SP + lane * 64);
        unsigned x[16];
#pragma unroll
        for (int d = 0; d < 16; ++d) x[d] = rd[d];
        if (f4) { u32x4 q;
            q.x = pk8f4(bflo(x[0]) * inv, bfhi(x[0]) * inv, bflo(x[1]) * inv, bfhi(x[1]) * inv, bflo(x[2]) * inv, bfhi(x[2]) * inv, bflo(x[3]) * inv, bfhi(x[3]) * inv);
            q.y = pk8f4(bflo(x[4]) * inv, bfhi(x[4]) * inv, bflo(x[5]) * inv, bfhi(x[5]) * inv, bflo(x[6]) * inv, bfhi(x[6]) * inv, bflo(x[7]) * inv, bfhi(x[7]) * inv);
            q.z = pk8f4(bflo(x[8]) * inv, bfhi(x[8]) * inv, bflo(x[9]) * inv, bfhi(x[9]) * inv, bflo(x[10]) * inv, bfhi(x[10]) * inv, bflo(x[11]) * inv, bfhi(x[11]) * inv);
            q.w = pk8f4(bflo(x[12]) * inv, bfhi(x[12]) * inv, bflo(x[13]) * inv, bfhi(x[13]) * inv, bflo(x[14]) * inv, bfhi(x[14]) * inv, bflo(x[15]) * inv, bfhi(x[15]) * inv);
            *(u32x4*)(w4 + (size_t)n * X4P + lane * 16) = q;
            if (lane == 0) sb4[n] = m * (1.0f / 6.0f);
            continue; }
        u32x4 q0, q1;
        q0.x = q8x4(bflo(x[0]) * inv, bfhi(x[0]) * inv, bflo(x[1]) * inv, bfhi(x[1]) * inv); q0.y = q8x4(bflo(x[2]) * inv, bfhi(x[2]) * inv, bflo(x[3]) * inv, bfhi(x[3]) * inv);
        q0.z = q8x4(bflo(x[4]) * inv, bfhi(x[4]) * inv, bflo(x[5]) * inv, bfhi(x[5]) * inv); q0.w = q8x4(bflo(x[6]) * inv, bfhi(x[6]) * inv, bflo(x[7]) * inv, bfhi(x[7]) * inv);
        q1.x = q8x4(bflo(x[8]) * inv, bfhi(x[8]) * inv, bflo(x[9]) * inv, bfhi(x[9]) * inv); q1.y = q8x4(bflo(x[10]) * inv, bfhi(x[10]) * inv, bflo(x[11]) * inv, bfhi(x[11]) * inv);
        q1.z = q8x4(bflo(x[12]) * inv, bfhi(x[12]) * inv, bflo(x[13]) * inv, bfhi(x[13]) * inv); q1.w = q8x4(bflo(x[14]) * inv, bfhi(x[14]) * inv, bflo(x[15]) * inv, bfhi(x[15]) * inv);
        u32x4* dst = (u32x4*)(w8 + (size_t)n * W8P + lane * 32);
        dst[0] = q0; dst[1] = q1;
        if (lane == 0) sb[n] = m * (1.0f / 127.0f); }
    asm volatile("s_waitcnt lgkmcnt(0)" ::: "memory");
    __syncthreads();
}
typedef const __attribute__((address_space(4))) Args CArgs;
#define PH_BEGIN() CArgs* ap = (CArgs*)__builtin_amdgcn_kernarg_segment_ptr(); asm volatile("" : "+s"(ap)); unsigned char* const ws = ap->ws; \
    int pt = wave * 64 + lane_id_v(); asm volatile("" : "+v"(pt)); const int lane = pt & 63; (void)lane; \
    const int G = gridDim.x, bx = blockIdx.x; (void)G; (void)bx
__global__ void __launch_bounds__(NWAVES * 64, 2) fwd(Args a) {
    extern __shared__ __attribute__((aligned(16))) unsigned char lds_raw[];
    LAS unsigned char* lds = (LAS unsigned char*)lds_raw;
    const int wave = __builtin_amdgcn_readfirstlane((int)threadIdx.x >> 6);
    const int lo = a.ph_lo, hi = a.ph_hi;
    volatile LAS unsigned* MISC = (volatile LAS unsigned*)(lds + MISC_OFF);
    if (threadIdx.x < 32) MISC[threadIdx.x] = 0u;
    for (int i = threadIdx.x; i < 4096; i += NWAVES * 64) lds[LUT_OFF + i] = (unsigned char)(unsigned)(255.0f / (1.0f + __expf(-(float)(i - 2048) * (1.0f / 256.0f))) + 0.5f);
    __syncthreads();
    XcdBarrier bar; bar.bar = (unsigned*)(a.ws + WS_CTL); bar.x = 0; bar.st = nullptr;
    if (hi - lo > 1) bar = xcd_barrier_post((unsigned*)(a.ws + WS_CTL), MISC + 8, threadIdx.x == 0);
#define xcd_barrier(b) xcd_barrier_(b, wave == 0 && lane_id_v() == 0)
#define BOTH(k) (IN(k) && IN((k) + 1))
#define IN(k) (lo <= (k) && (k) < hi)
#define VCU() ((G % 8 == 0) ? (bx % 8) * (G / 8) + bx / 8 : bx)
#ifndef PROBE_REP
#define PROBE_REP -1
#endif
#define NREP(k) ((PROBE_REP == (k)) ? 2 : 1)
#if defined(PROBE_MFMA)
    {
        const unsigned lz = (unsigned)lane_id_v() * 2654435761u + 12345u;
        i32x4 pa = {(int)(lz * 3u), (int)(lz * 5u + 7u), (int)(lz * 7u + 1u), (int)(lz * 11u + 3u)}, pb = {(int)(lz * 13u), (int)(lz * 17u + 7u), (int)(lz * 19u + 1u), (int)(lz * 23u + 3u)};
        pa &= 0x3f3f3f3f; pb &= 0x3f3f3f3f;
        f32x4 pd[8];
#pragma unroll
        for (int j = 0; j < 8; ++j) pd[j] = (f32x4){0.f, 0.f, 0.f, 0.f};
        const i32x8 pa8 = __builtin_shufflevector(pa, pb, 0, 1, 2, 3, 4, 5, 6, 7), pb8 = __builtin_shufflevector(pb, pa, 0, 1, 2, 3, 4, 5, 6, 7);
#pragma unroll 1
        for (int i = 0; i < 4000; ++i) {
#pragma unroll
            for (int j = 0; j < 8; ++j) {
                if (PROBE_MFMA == 1) pd[j] = __builtin_amdgcn_mfma_f32_16x16x32_bf16(__builtin_bit_cast(bf16x8, pa), __builtin_bit_cast(bf16x8, pb), pd[j], 0, 0, 0);
                else if (PROBE_MFMA == 2) pd[j] = __builtin_bit_cast(f32x4, __builtin_amdgcn_mfma_i32_16x16x64_i8(pa, pb, __builtin_bit_cast(i32x4, pd[j]), 0, 0, 0));
                else if (PROBE_MFMA == 3) { if (j < 4) pd[j] = __builtin_amdgcn_mfma_scale_f32_16x16x128_f8f6f4(pa8, pb8, pd[j], 0, 0, 0, 0, 0, 0); }
            }
        }
        float ps = 0.f;
#pragma unroll
        for (int j = 0; j < 8; ++j) ps += pd[j][0] + pd[j][1] + pd[j][2] + pd[j][3];
        if (ps == 1.2345678f) ((float*)(a.ws + WS_CTL))[200000] = ps;
    }
#endif
    for (int rep = 0; rep < NREP(100); ++rep) if (IN(0)) {
        PH_BEGIN();
        LAS unsigned char* scr = lds + RING_OFF + wave * 16384;
        const int gw = VCU() * NWAVES + wave, NGW = G * NWAVES;
        { const int xcd = bx & 7, tq = bx >> 3, pos = 8 * (xcd + 8 * (tq >> 3)) + (tq & 7);
          constexpr int NST = 8 * NI8;
          for (int sidx = pos; sidx < 2 * NST; sidx += 256) { const int L = sidx / NST, st = sidx % NST, t8 = st >> 3, t = i8_tile(t8), n0 = t * 256 + (st & 7) * 32, srcn = (n0 >= 14848) ? n0 - 188 : n0;
              const int nv = (n0 >= 14848) ? 32 : (14660 - n0 < 0 ? 0 : (14660 - n0 > 32 ? 32 : 14660 - n0));
              const bool f4 = is_f4(t); const int r4 = f4_index(f4 ? t : 58) * 256 + (st & 7) * 32;
              int scol = srcn + 4 * (lane & 7);
              if (t >= 16 && t < 32) { const int j0 = (st & 7) * 32 + 4 * (lane & 7), hf = j0 >> 7, g = (j0 & 127) >> 3, sub = (j0 >> 2) & 1;
                  scol = (hf == 0 ? (sub ? C_CC : C_CB) : (sub ? C_CG : C_CH)) + 64 * (t - 16) + 4 * g; }
              quant_strip(ap->w_in + (size_t)L * DM * NIN + scol, ws + WS_W8 + L * SZ_W8 + (size_t)n0 * W8P, (float*)(ws + WS_SB) + L * NP + n0, lds, (LAS float*)(lds + RING_BYTES + 1024), wave, lane, nv,
                          f4, ws + WS_W4 + L * SZ_WBR + (size_t)r4 * X4P, (float*)(ws + WS_SB4) + L * 6144 + r4); } }
        constexpr int NBB = 4 * NBF  , I_IN = (DM / 64) * NBB, I_KV = (DM / 64) * (2048 / 64), I_BR = (BW / 64) * (DM / 64), I_OUT = (DM / 64) * (DM / 64);
        constexpr int PER_L = I_IN + I_KV + 4 * I_BR + I_OUT;
        auto decode = [&](int it) -> TrItem {
            TrItem t; const int L = it / PER_L; int r = it % PER_L; t.f8 = false;
            if (r < I_IN) { const int kb = r / NBB, nbi = r % NBB, n0 = 256 * bf_tile(nbi >> 2) + 64 * (nbi & 3);
                t.src = ap->w_in + (size_t)L * DM * NIN + (size_t)(64 * kb) * NIN + n0; t.ldw = NIN; t.ldo = WKP; t.dst = (bf16_t*)(ws + WS_WIN + L * SZ_WIN) + (size_t)n0 * WKP + 64 * kb;
                t.valid = (n0 + (lane & 15) * 4 < 14660); return t; }
            r -= I_IN;
            if (r < I_KV) { const int nblk = 2048 / 64, kb = r / nblk, nb = r % nblk;
                t.src = ap->w_mem_kv + (size_t)L * DM * 2048 + (size_t)(64 * kb) * 2048 + 64 * nb; t.ldw = 2048; t.ldo = WKP; t.dst = (bf16_t*)(ws + WS_WKV + L * SZ_WKV) + (size_t)(64 * nb) * WKP + 64 * kb; t.valid = true; return t; }
            r -= I_KV;
            if (r < 4 * I_BR) { const int z = r / I_BR, rr = r % I_BR, nblk = DM / 64, kb = rr / nblk, nb = rr % nblk;
                t.src = ap->w_branch + ((size_t)L * 4 + z) * BW * DM + (size_t)(64 * kb) * DM + 64 * nb; t.ldw = DM; t.valid = true;
                if (z == 1) { t.ldo = WBP; t.dst = (bf16_t*)(ws + WS_WBR + L * SZ_WBR) + (size_t)z * DM * WBP + (size_t)(64 * nb) * WBP + 64 * kb; }
                else { const int slot = (z == 0) ? 0 : z - 1; t.f8 = true; t.ldo = WBP * 2; t.dst = (bf16_t*)(ws + WS_WB8 + L * SZ_WB8 + ((size_t)slot * DM + 64 * nb) * (WBP * 2) + 64 * kb); }
                return t; }
            r -= 4 * I_BR;
            { const int nblk = DM / 64, kb = r / nblk, nb = r % nblk;
              t.src = ap->w_out + (size_t)L * DM * DM + (size_t)(64 * kb) * DM + 64 * nb; t.ldw = DM; t.ldo = WKP; t.dst = (bf16_t*)(ws + WS_WOUT + L * SZ_WOUT) + (size_t)(64 * nb) * WKP + 64 * kb; t.valid = true; return t; }
        };
        {
            f32x4 va[16], vb[16];
            int it = gw;
            TrItem ta = decode(it < 2 * PER_L ? it : 0), tb = ta;
            if (it < 2 * PER_L) tr_load(ta, va, lane);
            for (; it < 2 * PER_L; it += 2 * NGW) {
                const bool hb = (it + NGW < 2 * PER_L);
                if (hb) { tb = decode(it + NGW); tr_load(tb, vb, lane); }
                tr_store(ta, va, scr, lane);
                if (it + 2 * NGW < 2 * PER_L) { ta = decode(it + 2 * NGW); tr_load(ta, va, lane); }
                if (hb) tr_store(tb, vb, scr, lane);
            }
        }
        if (M % (2 * NGW) == 0) { for (int m = gw; m < M; m += 2 * NGW) rms_rows<false, 2>(ap->x + (size_t)m * DM, (size_t)NGW * DM, ap->ln_g, (bf16_t*)(ws + WS_XN) + (size_t)m * XNP, (size_t)NGW * XNP * 2, lane, ws + WS_XN8 + (size_t)m * XN8P, (size_t)NGW * XN8P, (float*)(ws + WS_SA) + m, (size_t)NGW, ws + WS_XN4 + (size_t)m * X4P, (size_t)NGW * X4P, (float*)(ws + WS_SA4) + m); }
        else { for (int m = gw; m < M; m += NGW) rms_rows<false, 1>(ap->x + (size_t)m * DM, 0, ap->ln_g, (bf16_t*)(ws + WS_XN) + (size_t)m * XNP, 0, lane, ws + WS_XN8 + (size_t)m * XN8P, 0, (float*)(ws + WS_SA) + m, 0, ws + WS_XN4 + (size_t)m * X4P, 0, (float*)(ws + WS_SA4) + m); }
        for (int m = gw; m < 2 * 1024; m += NGW) { const int L = m / 1024, r = m % 1024;
            rms_row<false>(ap->mem + (size_t)r * DM, ap->mem_ln_g + L * DM, (bf16_t*)(ws + WS_MEMN) + (size_t)m * WKP, lane); }
        if (BOTH(0)) xcd_barrier(bar);
    }
    if (IN(1)) {
        PH_BEGIN();
        { pg8::Gemm g{(const bf16_t*)(ws + WS_MEMN), (const bf16_t*)(ws + WS_WKV), DM, WKP, WKP, (size_t)1024 * WKP * 2, SZ_WKV, 0};
          pg8::Sched S{4, 4, 2, 0, G, (bx + 96) % G}; pg8::EpiBf16 E{(bf16_t*)(ws + WS_MK), 1024, (size_t)1024 * 1024};
          pg8::gemm_phase<pg8::EpiBf16, true>(lds + RING_OFF, g, S, E, wave); }
        { pg8::Gemm g{(const bf16_t*)(ws + WS_WKV) + (size_t)1024 * WKP, (const bf16_t*)(ws + WS_MEMN), DM, WKP, WKP, SZ_WKV, (size_t)1024 * WKP * 2, 0};
          pg8::Sched S{4, 4, 2, 0, G, (bx + 128) % G}; pg8::EpiBf16 E{(bf16_t*)(ws + WS_VT), 1024, (size_t)1024 * 1024};
          pg8::gemm_phase<pg8::EpiBf16, true>(lds + RING_OFF, g, S, E, wave); }
    }
#pragma unroll 1
    for (int L = 0; L < 2; ++L) {
        const int pb = 2 + 6 * L;
        for (int rep = 0; rep < NREP(0); ++rep) if (IN(pb + 0)) {
            PH_BEGIN();
            for (int r9 = 0; r9 < NREP(9); ++r9) { pg8::Gemm g{(const bf16_t*)(ws + WS_XN8), (const bf16_t*)(ws + WS_W8 + L * SZ_W8), DM / 2, XN8P / 2, W8P / 2, 0, 0, 0};
              #ifdef ATT_CHECK
              pg8::Sched S{M / 256, NI8, 1, 0, G, bx, 1};
#else
              pg8::Sched S{M / 256, NI8 - 32, 1, 0, G, bx, 1, (G == 256 && NI8 == 88) ? 13 : 0};
#endif
              pg8::EpiInProj<true> E{(bf16_t*)(ws + WS_PO), (float*)(ws + WS_IDX), (bf16_t*)(ws + WS_IQC), (bf16_t*)(ws + WS_IKC), ws + WS_G8, (const float*)(ws + WS_SA), (const float*)(ws + WS_SB) + L * NP, (const LAS unsigned char*)(lds + LUT_OFF), (LAS float*)(lds + RING_BYTES + 1024), ws + WS_K8};
              pg8::gemm_phase<pg8::EpiInProj<true>, true, 1>(lds + RING_OFF, g, S, E, wave, r9 > 0); }
            { PH_BEGIN();
              pg8::Gemm g{(const bf16_t*)(ws + WS_XN4), (const bf16_t*)(ws + WS_W4 + L * SZ_WBR), DM / 4, X4P / 2, X4P / 2, 0, 0, 0};
              pg8::Sched S{M / 256, 24, 1, 0, G, bx, 0};
              pg8::EpiGate4 E{ws + WS_G8, (const float*)(ws + WS_SA4), (const float*)(ws + WS_SB4) + L * 6144, (const LAS unsigned char*)(lds + LUT_OFF), (LAS float*)(lds + RING_BYTES + 1024)};
              pg8::gemm_phase<pg8::EpiGate4, true, 3>(lds + RING_OFF, g, S, E, wave); }
            { PH_BEGIN();
              pg8::Gemm g{(const bf16_t*)(ws + WS_W8 + L * SZ_W8), (const bf16_t*)(ws + WS_XN8), DM / 2, W8P / 2, XN8P / 2, 0, 0, 0};
              pg8::Sched S{8, M / 256, 1, 0, G, bx, 3};
              pg8::EpiVT E{ws + WS_VT8, (const float*)(ws + WS_SB) + L * NP, (const float*)(ws + WS_SA), (LAS float*)(lds + RING_BYTES + 1024)};
              pg8::gemm_phase<pg8::EpiVT, true, 1>(lds + RING_OFF, g, S, E, wave); }
            for (int r10 = 0; r10 < NREP(10); ++r10) { PH_BEGIN();
              pg8::Gemm g{(const bf16_t*)(ws + WS_XN), (const bf16_t*)(ws + WS_WIN + L * SZ_WIN), DM, XNP, WKP, 0, 0, 0};
              pg8::Sched S{M / 256, NBF, 1, 0, G, bx, 2};
              pg8::EpiInProj<false> E{(bf16_t*)(ws + WS_PO), (float*)(ws + WS_IDX), (bf16_t*)(ws + WS_IQC), (bf16_t*)(ws + WS_IKC), ws + WS_G8, nullptr, nullptr, nullptr, nullptr, nullptr};
              pg8::gemm_phase<pg8::EpiInProj<false>, true, 0>(lds + RING_OFF, g, S, E, wave); }
            if (BOTH(pb + 0)) xcd_barrier(bar);
        }
        for (int rep = 0; rep < NREP(1); ++rep) if (IN(pb + 1)) {
            { PH_BEGIN(); const bf16_t* PO = (const bf16_t*)(ws + WS_PO);
              const int gw = VCU() * NWAVES + wave, NGW = G * NWAVES;
              for (int u = 2 * bx; u < 512; u += 2 * G) kmean_pair(ws + WS_K8, (float*)(ws + WS_KMEAN), u, (u + 1 < 512) ? u + 1 : -1, wave, lane, (LAS float*)(lds + RING_OFF));
              for (int r8 = 0; r8 < NREP(8); ++r8) conv_phase(PO, ap->conv_w + (size_t)L * 3 * BW, ap->conv_b + (size_t)L * BW, ws + WS_Y, bx * 512 + pt, G * 512); }
            for (int r7 = 0; r7 < NREP(7); ++r7) { PH_BEGIN(); pg8::Gemm g{(const bf16_t*)(ws + WS_PO) + C_MQ, (const bf16_t*)(ws + WS_MK) + (size_t)L * 1024 * 1024, 256, NPO, 1024, 512, 512, (size_t)256 * 1024 * 2};
              pg8::Sched S{M / 256, 1, 4, 0, G, bx}; pg8::EpiSoftmax E{(bf16_t*)(ws + WS_PM), (LAS float*)(lds + RING_BYTES + 1024)};
              pg8::gemm_phase<pg8::EpiSoftmax, true>(lds + RING_OFF, g, S, E, wave); }
            __syncthreads();
            { PH_BEGIN(); const bf16_t* IQC = (const bf16_t*)(ws + WS_IQC); const bf16_t* IKC = (const bf16_t*)(ws + WS_IKC); const float* IDX = (const float*)(ws + WS_IDX); unsigned* maskw = (unsigned*)(ws + WS_MASK);
              for (int r6 = 0; r6 < NREP(6); ++r6) for (int v = bx; v < 256; v += G) { const int tb = v >> 6, ti = v & 63; unsigned* scr = (unsigned*)(ws + WS_SCR) + (size_t)bx * (512 * 1024 / 4); for (int hh2 = 0; hh2 < 2; ++hh2) { const int uu = hh2 ? ti : 127 - ti; tk::topk_unit(IQC, IKC, IDX, maskw, scr, tb, uu, (LAS char*)lds, wave);
#ifdef TK_CHECK
                  { unsigned* maskw2 = (unsigned*)(ws + WS_MASK2); tk::topk_unit(IQC, IKC, IDX, maskw2, scr, tb, uu, (LAS char*)lds, wave, 1);
                    const int q = pt >> 4, c = pt & 15;
                    if (c <= (uu >> 3)) { const size_t o = ((size_t)tb * SEQ + uu * 32 + q) * 128 + 8 * c; bool bad = false;
                        for (int e = 0; e < 8; ++e) bad |= (maskw[o + e] != maskw2[o + e]);
                        if (bad) __hip_atomic_fetch_or((unsigned*)(ws + WS_CTL) + 12000, 1u, __ATOMIC_RELAXED, __HIP_MEMORY_SCOPE_AGENT); } }
#endif
              } } }
            if (BOTH(pb + 1)) xcd_barrier(bar);
        }
        for (int rep = 0; rep < NREP(2); ++rep) if (IN(pb + 2)) {
            { PH_BEGIN(); pg8::Gemm g{(const bf16_t*)(ws + WS_PM), (const bf16_t*)(ws + WS_VT) + (size_t)L * 1024 * 1024, 256, 1024, 1024, 512, (size_t)256 * 1024 * 2, 512};
              pg8::Sched S{M / 256, 1, 4, 0, G, bx}; pg8::EpiMemOut E{(const bf16_t*)(ws + WS_PO), ws + WS_Y};
              pg8::gemm_phase<pg8::EpiMemOut, true>(lds + RING_OFF, g, S, E, wave); }
            for (;;) {
                PH_BEGIN(); const bf16_t* PO = (const bf16_t*)(ws + WS_PO); unsigned char* Y = ws + WS_Y;
                if (pt == 0) MISC[4] = __hip_atomic_fetch_add((unsigned*)(ws + WS_CTL) + 8192 + 64 * L + 256 * rep, 1u, __ATOMIC_RELAXED, __HIP_MEMORY_SCOPE_AGENT);
                __syncthreads();
                const unsigned u = MISC[4];
                __syncthreads();
                if (u >= 1024u) break;
                const int qb = 15 - (int)(u >> 6), mode = (u >> 5) & 1, bb = (u >> 3) & 3, hh = u & 7;
                const size_t tok0 = (size_t)bb * SEQ + (size_t)qb * 256;
                const unsigned char* K8 = ws + WS_K8 + ((size_t)mode * M + (size_t)bb * SEQ) * 1024 + hh * 128; const unsigned char* VT = ws + WS_VT8 + (size_t)(mode * 1024 + hh * 128) * VTP + (size_t)bb * SEQ;
#ifndef ATT_NEW0
#define ATT_NEW0 1
#endif
#ifndef ATT_NEW1
#define ATT_NEW1 1
#endif
                if (mode == 0) { if (ATT_NEW0) att::attn_unit8<0>(PO + tok0 * NPO + C_AQ + hh * 128, K8, VT, (const unsigned char*)(PO + tok0 * NPO + C_AG) + hh * 128,
                                                  Y + tok0 * YB + hh * 128, (const float*)(ws + WS_KMEAN) + (size_t)(bb * 8 + hh) * 16 * 128, nullptr, qb, (LAS char*)lds, wave, (unsigned*)(ws + WS_CTL) + 12200);
                    else att::attn_unit<0>(PO + tok0 * NPO + C_AQ + hh * 128, PO + (size_t)bb * SEQ * NPO + C_AK + hh * 128, PO + (size_t)bb * SEQ * NPO + C_AV + hh * 128, PO + tok0 * NPO + C_AG + hh * 128,
                                                 Y + tok0 * YB + hh * 128, (const float*)(ws + WS_KMEAN) + (size_t)(bb * 8 + hh) * 16 * 128, nullptr, qb, (LAS char*)lds, wave); }
                else { if (ATT_NEW1) att::attn_unit8<1>(PO + tok0 * NPO + C_SQ + hh * 128, K8, VT, (const unsigned char*)(PO + tok0 * NPO + C_SG) + hh * 128,
                                        Y + tok0 * YB + 1024 + hh * 128, nullptr, (const unsigned*)(ws + WS_MASK) + tok0 * 128, qb, (LAS char*)lds, wave, (unsigned*)(ws + WS_CTL) + 12200);
                    else att::attn_unit<1>(PO + tok0 * NPO + C_SQ + hh * 128, PO + (size_t)bb * SEQ * NPO + C_SK + hh * 128, PO + (size_t)bb * SEQ * NPO + C_SV + hh * 128, PO + tok0 * NPO + C_SG + hh * 128,
                                       Y + tok0 * YB + 1024 + hh * 128, nullptr, (const unsigned*)(ws + WS_MASK) + tok0 * 128, qb, (LAS char*)lds, wave); }
#if defined(ATT_CHECK) && defined(ATT_CMP)
                {
                    unsigned char* Yu = Y + tok0 * YB + (mode ? 1024 : 0) + hh * 128 + (size_t)((pt >> 6) * 32) * YB;
                    u32x2* sv = (u32x2*)((unsigned*)(ws + WS_SCR) + (size_t)bx * (512 * 1024 / 4)) + pt * 8;
                    const int ln = pt & 63;
#pragma unroll
                    for (int i = 0; i < 8; ++i) { const int k = ln + 64 * i, row = k >> 4, cc = (k & 15) * 8; sv[i] = *(const u32x2*)(Yu + (size_t)row * YB + cc); }
                    __syncthreads();
                    if (mode == 0) att::attn_unit<0>(PO + tok0 * NPO + C_AQ + hh * 128, PO + (size_t)bb * SEQ * NPO + C_AK + hh * 128, PO + (size_t)bb * SEQ * NPO + C_AV + hh * 128, PO + tok0 * NPO + C_AG + hh * 128,
                                                     Y + tok0 * YB + hh * 128, (const float*)(ws + WS_KMEAN) + (size_t)(bb * 8 + hh) * 16 * 128, nullptr, qb, (LAS char*)lds, wave);
                    else att::attn_unit<1>(PO + tok0 * NPO + C_SQ + hh * 128, PO + (size_t)bb * SEQ * NPO + C_SK + hh * 128, PO + (size_t)bb * SEQ * NPO + C_SV + hh * 128, PO + tok0 * NPO + C_SG + hh * 128,
                                           Y + tok0 * YB + 1024 + hh * 128, nullptr, (const unsigned*)(ws + WS_MASK) + tok0 * 128, qb, (LAS char*)lds, wave);
                    float d2 = 0.f, r2 = 0.f;
#pragma unroll
                    for (int i = 0; i < 8; ++i) { const int k = ln + 64 * i, row = k >> 4, cc = (k & 15) * 8; const u32x2 a = sv[i], b = *(const u32x2*)(Yu + (size_t)row * YB + cc);
#pragma unroll
                        for (int h2 = 0; h2 < 2; ++h2) { const int aw = (int)(h2 ? a.y : a.x), bw = (int)(h2 ? b.y : b.x);
                            const f32x2 a0 = __builtin_amdgcn_cvt_pk_f32_fp8(aw, false), a1 = __builtin_amdgcn_cvt_pk_f32_fp8(aw, true), b0 = __builtin_amdgcn_cvt_pk_f32_fp8(bw, false), b1 = __builtin_amdgcn_cvt_pk_f32_fp8(bw, true);
                            d2 += (a0[0] - b0[0]) * (a0[0] - b0[0]) + (a0[1] - b0[1]) * (a0[1] - b0[1]) + (a1[0] - b1[0]) * (a1[0] - b1[0]) + (a1[1] - b1[1]) * (a1[1] - b1[1]);
                            r2 += b0[0] * b0[0] + b0[1] * b0[1] + b1[0] * b1[0] + b1[1] * b1[1]; } }
                    d2 = wave_sum(d2); r2 = wave_sum(r2);
                    if (ln == 0) { atomicAdd((float*)(ws + WS_CTL) + 12100 + 2 * mode, d2); atomicAdd((float*)(ws + WS_CTL) + 12101 + 2 * mode, r2); }
                }
#endif
            }
            if (BOTH(pb + 2)) xcd_barrier(bar);
        }
        for (int rep = 0; rep < NREP(3); ++rep) if (IN(pb + 3)) {
            PH_BEGIN();
            for (int r11 = 0; r11 < NREP(11); ++r11) { pg8::Gemm g{(const bf16_t*)(ws + WS_Y + 3072), (const bf16_t*)(ws + WS_WBR + L * SZ_WBR) + (size_t)DM * WBP, BW, YB / 2, WBP, 0, 0, 0};
              pg8::Sched S{M / 256, DM / 256, 1, 0, G, bx};
              pg8::EpiMergeC E{(bf16_t*)(ws + WS_PO), ws + WS_G8};
              pg8::gemm_phase<pg8::EpiMergeC, true, 0>(lds + RING_OFF, g, S, E, wave); }
            for (int r12 = 0; r12 < NREP(12); ++r12) { PH_BEGIN();
              pg8::Gemm g{(const bf16_t*)(ws + WS_Y), (const bf16_t*)(ws + WS_WB8 + L * SZ_WB8), BW / 2, YB / 2, WBP, (size_t)BW, (size_t)DM * WBP * 2, 0};
              pg8::Sched S{M / 256, DM / 256, 3, 1, G, bx};
              pg8::EpiMerge E{(bf16_t*)(ws + WS_PO), ws + WS_G8};
              pg8::gemm_phase<pg8::EpiMerge, true, 2>(lds + RING_OFF, g, S, E, wave); }
            if (BOTH(pb + 3)) xcd_barrier(bar);
        }
        for (int rep = 0; rep < ((L == 0) ? NREP(4) : 1); ++rep) if (IN(pb + 4)) {
            PH_BEGIN();
            pg8::Gemm g{(const bf16_t*)(ws + WS_PO) + 4096, (const bf16_t*)(ws + WS_WOUT + L * SZ_WOUT), DM, NPO, WKP, 0, 0, 0};
            pg8::Sched S{M / 256, DM / 256, 1, 0, G, bx};
            if (L == 0) { pg8::EpiOut<1> E{ap->x, (bf16_t*)(ws + WS_X1)}; pg8::gemm_phase<pg8::EpiOut<1>, true>(lds + RING_OFF, g, S, E, wave); }
            else { pg8::EpiOut<2> E{ap->x, (bf16_t*)(ws + WS_X1)}; pg8::gemm_phase<pg8::EpiOut<2>, true>(lds + RING_OFF, g, S, E, wave); }
            if (BOTH(pb + 4)) xcd_barrier(bar);
        }
        for (int rep = 0; rep < ((L == 0) ? NREP(5) : 1); ++rep) if (IN(pb + 5)) {
            PH_BEGIN();
            const int gw = VCU() * NWAVES + wave, NGW = G * NWAVES; float* out = ap->out;
            if (M % (2 * NGW) != 0) { if (L == 0) { for (int m = gw; m < M; m += NGW) rms_rows<false, 1, true>((const float*)((const bf16_t*)(ws + WS_X1) + (size_t)m * DM), 0, ap->ln_g + DM, (bf16_t*)(ws + WS_XN) + (size_t)m * XNP, 0, lane, ws + WS_XN8 + (size_t)m * XN8P, 0, (float*)(ws + WS_SA) + m, 0, ws + WS_XN4 + (size_t)m * X4P, 0, (float*)(ws + WS_SA4) + m); } else { for (int m = gw; m < M; m += NGW) rms_rows<true, 1, true>((const float*)((const bf16_t*)(ws + WS_X1) + (size_t)m * DM), 0, ap->final_g, out + (size_t)m * DM, 0, lane); } }
            else if (L == 0) { for (int m = gw; m < M; m += 2 * NGW) rms_rows<false, 2, true>((const float*)((const bf16_t*)(ws + WS_X1) + (size_t)m * DM), (size_t)NGW * DM, ap->ln_g + DM, (bf16_t*)(ws + WS_XN) + (size_t)m * XNP, (size_t)NGW * XNP * 2, lane, ws + WS_XN8 + (size_t)m * XN8P, (size_t)NGW * XN8P, (float*)(ws + WS_SA) + m, (size_t)NGW, ws + WS_XN4 + (size_t)m * X4P, (size_t)NGW * X4P, (float*)(ws + WS_SA4) + m); }
            else { for (int m = gw; m < M; m += 2 * NGW) rms_rows<true, 2, true>((const float*)((const bf16_t*)(ws + WS_X1) + (size_t)m * DM), (size_t)NGW * DM, ap->final_g, out + (size_t)m * DM, (size_t)NGW * DM * 4, lane); }
#if defined(ATT_CHECK) && defined(ATT_CMP)
            if (L == 1 && gw == 0 && lane == 0) { bool bad = false;
                for (int md = 0; md < 2; ++md) { const float d2 = __hip_atomic_load((float*)(ws + WS_CTL) + 12100 + 2 * md, __ATOMIC_RELAXED, __HIP_MEMORY_SCOPE_AGENT), r2 = __hip_atomic_load((float*)(ws + WS_CTL) + 12101 + 2 * md, __ATOMIC_RELAXED, __HIP_MEMORY_SCOPE_AGENT);
                    bad |= !(d2 <= ATT_CMP * r2) || !(r2 > 0.f); }
                if (bad) { asm volatile("s_waitcnt vmcnt(0)" ::: "memory"); out[0] = __builtin_nanf(""); } }
#endif
#ifdef ATT_LSUM_CHECK
            if (L == 1 && gw == 0 && lane == 0 && __hip_atomic_load((unsigned*)(ws + WS_CTL) + 12200, __ATOMIC_RELAXED, __HIP_MEMORY_SCOPE_AGENT) != 0u) { asm volatile("s_waitcnt vmcnt(0)" ::: "memory"); out[0] = __builtin_nanf(""); }
#endif
#ifdef TK_CHECK
            if (L == 1 && gw == 0 && lane == 0 && __hip_atomic_load((unsigned*)(ws + WS_CTL) + 12000, __ATOMIC_RELAXED, __HIP_MEMORY_SCOPE_AGENT) != 0u) { asm volatile("s_waitcnt vmcnt(0)" ::: "memory"); out[0] = __builtin_nanf(""); }
#endif
            if (L == 0 && BOTH(pb + 5)) xcd_barrier(bar);
        }
    }
#undef IN
#undef BOTH
}

extern "C" void kernel_launch(void* const* d_in, const int* in_sizes, int n_in, void* d_out, int out_size, void* d_ws, size_t ws_size, hipStream_t stream) {
    static int grid = 0;
    if (grid == 0) {
        if (n_in != 11 || out_size != M * DM || ws_size < WS_END2) { fprintf(stderr, "kernel_launch: unexpected shapes (n_in %d out %d ws %zu need %zu)\n", n_in, out_size, ws_size, (size_t)WS_END); grid = -1; return; }
        int dev = 0, cus = 0;
        if (hipGetDevice(&dev) != hipSuccess || hipDeviceGetAttribute(&cus, hipDeviceAttributeMultiprocessorCount, dev) != hipSuccess) { grid = -1; return; }
        if (hipFuncSetAttribute((const void*)fwd, hipFuncAttributeMaxDynamicSharedMemorySize, LDS_BYTES) != hipSuccess) { fprintf(stderr, "kernel_launch: hipFuncSetAttribute failed\n"); grid = -1; return; }
        grid = cus;
    }
    if (grid < 0) return;
    Args a{};
    a.x = (const float*)d_in[0]; a.mem = (const float*)d_in[1]; a.ln_g = (const float*)d_in[2]; a.w_in = (const float*)d_in[3]; a.conv_w = (const float*)d_in[4]; a.conv_b = (const float*)d_in[5];
    a.mem_ln_g = (const float*)d_in[6]; a.w_mem_kv = (const float*)d_in[7]; a.w_branch = (const float*)d_in[8]; a.w_out = (const float*)d_in[9]; a.final_g = (const float*)d_in[10];
    a.out = (float*)d_out; a.ws = (unsigned char*)d_ws;
    unsigned char* ws = (unsigned char*)d_ws;
    if (hipMemsetAsync(ws + WS_CTL, 0, 65536, stream) != hipSuccess) { fprintf(stderr, "kernel_launch: memset failed\n"); return; }
    a.ph_lo = 0; a.ph_hi = 14;
    hipLaunchKernelGGL(fwd, dim3(grid), dim3(NWAVES * 64), LDS_BYTES, stream, a);
    const hipError_t le = hipPeekAtLastError();
    if (le != hipSuccess) fprintf(stderr, "kernel_launch: launch failed: %s\n", hipGetErrorName(le));
}
```
